# Optimizing an MI355X kernel written in HIP

```python
import jax, jax.numpy as jnp
from jax import lax
import numpy as np

D_MODEL = 1024
BATCH = 8
SEQ = 4096
DEPTH = 1

CHUNK = 64
EPS = 1e-6

POOL_WIDTH = D_MODEL
POOL_WINDOWS = (2, 4, 8, 16)
POOL_GROUPS = len(POOL_WINDOWS)
POOL_GROUP_DIM = POOL_WIDTH // POOL_GROUPS

GLA_HEADS = 4
GLA_KEY_DIM = D_MODEL // 2
GLA_VAL_DIM = D_MODEL
GLA_HEAD_K = GLA_KEY_DIM // GLA_HEADS
GLA_HEAD_V = GLA_VAL_DIM // GLA_HEADS
GLA_GATE_RANK = 16
GLA_GATE_NORMALIZER = 16.0

SPLITS = (
    POOL_WIDTH,
    POOL_WIDTH,
    GLA_KEY_DIM,
    GLA_KEY_DIM,
    GLA_VAL_DIM,
    GLA_VAL_DIM,
    GLA_GATE_RANK,
    D_MODEL,
    D_MODEL,
)
IN_WIDTH = sum(SPLITS)
SPLIT_POINTS = tuple(int(v) for v in np.cumsum(SPLITS)[:-1])

kernel_name = "hybrid_pool_gla_gated_merge"


def rmsnorm(x, gain):
    xf = x.astype(jnp.float32)
    y = xf * lax.rsqrt(jnp.mean(xf * xf, axis=-1, keepdims=True) + EPS)
    return (y * gain.astype(jnp.float32)).astype(x.dtype)


def causal_multiscale_pool(u):
    B, S, _ = u.shape
    ug = u.reshape(B, S, POOL_GROUPS, POOL_GROUP_DIM).astype(jnp.float32)
    cs = jnp.cumsum(ug, axis=1)
    t = jnp.arange(1, S + 1, dtype=jnp.float32)
    outs = []
    for gi, w in enumerate(POOL_WINDOWS):
        csg = cs[:, :, gi]
        prev = jnp.pad(csg, ((0, 0), (w, 0), (0, 0)))[:, :S]
        cnt = jnp.minimum(t, float(w))[None, :, None]
        outs.append((csg - prev) / cnt)
    mean = jnp.stack(outs, axis=2)
    return (mean - ug).astype(u.dtype)


def gla_chunked(q, k, v, log_a):
    B, S, H, dk = q.shape
    dv = v.shape[-1]
    N = S // CHUNK

    def to_chunks(t):
        return t.reshape(B, N, CHUNK, H, -1).transpose(0, 3, 1, 2, 4)

    qc = to_chunks(q.astype(jnp.float32)) * (dk ** -0.5)
    kc = to_chunks(k.astype(jnp.float32))
    vc = to_chunks(v.astype(jnp.float32))
    gc = to_chunks(log_a.astype(jnp.float32))
    b = jnp.cumsum(gc, axis=3)
    b_last = b[:, :, :, -1:, :]
    q_dec = qc * jnp.exp(b)
    k_inv = kc * jnp.exp(-b)
    k_to_end = kc * jnp.exp(b_last - b)
    decay_chunk = jnp.exp(b_last[:, :, :, 0, :])

    mask = jnp.tril(jnp.ones((CHUNK, CHUNK), dtype=bool))
    scores = jnp.einsum('bhnid,bhnjd->bhnij', q_dec, k_inv)
    scores = jnp.where(mask, scores, 0.0)
    o_intra = jnp.einsum('bhnij,bhnjv->bhniv', scores, vc)

    def step(state, inp):
        q_n, k_n, v_n, dec_n = inp
        o_n = jnp.einsum('bhid,bhdv->bhiv', q_n, state)
        state = state * dec_n[..., None] + jnp.einsum('bhjd,bhjv->bhdv', k_n, v_n)
        return state, o_n

    xs = (q_dec.transpose(2, 0, 1, 3, 4), k_to_end.transpose(2, 0, 1, 3, 4),
          vc.transpose(2, 0, 1, 3, 4), decay_chunk.transpose(2, 0, 1, 3))
    s0 = jnp.zeros((B, H, dk, dv), jnp.float32)
    _, o_inter = lax.scan(step, s0, xs)
    o = o_intra + o_inter.transpose(1, 2, 0, 3, 4)
    return o.transpose(0, 2, 3, 1, 4).reshape(B, S, H, dv).astype(q.dtype)


def hybrid_layer(x, c, g_norm, w_ada, b_ada, w_in, w_pool_group, pool_scale,
                 w_alpha_up, b_alpha, g_gla_head, w_pool_out, w_gla_out, w_out):
    B, S, D = x.shape
    mod = jax.nn.silu(c) @ w_ada + b_ada
    shift, scale, gate = jnp.split(mod, 3, axis=-1)
    h = rmsnorm(x, g_norm) * (1.0 + scale[:, None]) + shift[:, None]

    z = h @ w_in
    (pv, pg, q, k, v, gg, a_low, mg_pool, mg_gla) = jnp.split(z, SPLIT_POINTS, axis=-1)

    pooled = causal_multiscale_pool(pv)
    mixed = jnp.einsum('bsgc,gcd->bsgd', pooled, w_pool_group).reshape(B, S, POOL_WIDTH)
    y_pool = mixed * pool_scale * jax.nn.silu(pg)

    log_a = jax.nn.log_sigmoid((a_low @ w_alpha_up + b_alpha).astype(jnp.float32)) / GLA_GATE_NORMALIZER
    o = gla_chunked(q.reshape(B, S, GLA_HEADS, GLA_HEAD_K),
                    k.reshape(B, S, GLA_HEADS, GLA_HEAD_K),
                    v.reshape(B, S, GLA_HEADS, GLA_HEAD_V),
                    log_a.reshape(B, S, GLA_HEADS, GLA_HEAD_K))
    o = rmsnorm(o, g_gla_head).reshape(B, S, GLA_VAL_DIM)
    y_gla = o * jax.nn.silu(gg)

    merged = (jax.nn.sigmoid(mg_pool) * (y_pool @ w_pool_out)
              + jax.nn.sigmoid(mg_gla) * (y_gla @ w_gla_out))
    out = merged @ w_out
    return x + gate[:, None] * out


def setup_inputs(seed: int = 0) -> dict:
    key = jax.random.key(seed)
    ks = jax.random.split(key, 16)
    D = D_MODEL
    f32 = jnp.float32
    nrm = lambda k, shape, s: (jax.random.normal(k, shape, f32) * s)
    return {
        "x": nrm(ks[0], (BATCH, SEQ, D), 1.0),
        "c": nrm(ks[1], (BATCH, D), 1.0),
        "g_norm": 1.0 + nrm(ks[2], (DEPTH, D), 0.02),
        "w_ada": nrm(ks[3], (DEPTH, D, 3 * D), 0.5 * D ** -0.5),
        "b_ada": nrm(ks[4], (DEPTH, 3 * D), 0.02),
        "w_in": nrm(ks[5], (DEPTH, D, IN_WIDTH), D ** -0.5),
        "w_pool_group": nrm(ks[6], (DEPTH, POOL_GROUPS, POOL_GROUP_DIM, POOL_GROUP_DIM), POOL_GROUP_DIM ** -0.5),
        "pool_scale": 1.0 + nrm(ks[7], (DEPTH, POOL_WIDTH), 0.1),
        "w_alpha_up": nrm(ks[8], (DEPTH, GLA_GATE_RANK, GLA_KEY_DIM), GLA_GATE_RANK ** -0.5),
        "b_alpha": nrm(ks[9], (DEPTH, GLA_KEY_DIM), 0.1),
        "g_gla_head": 1.0 + nrm(ks[10], (DEPTH, GLA_HEAD_V), 0.02),
        "w_pool_out": nrm(ks[11], (DEPTH, POOL_WIDTH, D), POOL_WIDTH ** -0.5),
        "w_gla_out": nrm(ks[12], (DEPTH, GLA_VAL_DIM, D), GLA_VAL_DIM ** -0.5),
        "w_out": nrm(ks[13], (DEPTH, D, D), D ** -0.5),
        "g_final": 1.0 + nrm(ks[14], (D,), 0.02),
    }


def reference(x, c, g_norm, w_ada, b_ada, w_in, w_pool_group, pool_scale,
              w_alpha_up, b_alpha, g_gla_head, w_pool_out, w_gla_out, w_out, g_final):
    h = x
    for l in range(DEPTH):
        h = hybrid_layer(h, c, g_norm[l], w_ada[l], b_ada[l], w_in[l], w_pool_group[l],
                         pool_scale[l], w_alpha_up[l], b_alpha[l], g_gla_head[l],
                         w_pool_out[l], w_gla_out[l], w_out[l])
    return rmsnorm(h, g_final)
```

```cpp
#include <hip/hip_runtime.h>
#include <hip/hip_cooperative_groups.h>
#include <cstdio>
namespace cg = cooperative_groups;

#define LAS __attribute__((address_space(3)))
typedef unsigned short bf16_t;
typedef short bf16x8 __attribute__((ext_vector_type(8)));
typedef float f32x4 __attribute__((ext_vector_type(4)));
typedef unsigned u32x4 __attribute__((ext_vector_type(4)));
typedef unsigned u32x2 __attribute__((ext_vector_type(2)));

constexpr int DM = 1024, NB = 8, SEQ = 4096, MTOK = NB * SEQ;
constexpr int INW = 7184, ZLD = 7168;
constexpr int ZC_PV = 0, ZC_SPG = 1024, ZC_Q = 2048, ZC_K = 2560, ZC_V = 3072, ZC_SGG = 4096, ZC_SMP = 5120, ZC_SMG = 6144;
constexpr int ZC_YPOOL = 0, ZC_MERGED = 1024, ZC_POOLED = 2048, ZC_T = 2048, ZC_YGLA = 4096;
constexpr float EPSV = 1e-6f;
constexpr size_t WS_Z = 0;
constexpr size_t WS_WINT = WS_Z + (size_t)MTOK * ZLD * 2;
constexpr size_t WS_WPGT = WS_WINT + (size_t)ZLD * 1024 * 2;
constexpr size_t WS_WPOT = WS_WPGT + (size_t)1024 * 256 * 2;
constexpr size_t WS_WGOT = WS_WPOT + (size_t)1024 * 1024 * 2;
constexpr size_t WS_WOT = WS_WGOT + (size_t)1024 * 1024 * 2;
constexpr size_t WS_MOD = WS_WOT + (size_t)1024 * 1024 * 2;
constexpr size_t WS_ALOW = WS_MOD + (size_t)8 * 3072 * 4;
constexpr size_t WS_PG = WS_ALOW + (size_t)MTOK * 16 * 4;
constexpr size_t WS_DEC = WS_PG + (size_t)2048 * 4096 * 2;
constexpr size_t WS_BAR = WS_DEC + (size_t)2048 * 128 * 4;
constexpr size_t WS_END = WS_BAR + 256;
constexpr size_t DO_H = 0;
constexpr size_t DO_QD = 0;
constexpr size_t DO_KET = (size_t)MTOK * 512 * 2;
constexpr size_t DO_O = (size_t)MTOK * 1024 * 2;
constexpr int LDS_BYTES = 131072;

struct Params {
    const float *x, *c, *g_norm, *w_ada, *b_ada, *w_in, *w_pg, *pool_scale, *w_up, *b_alpha, *g_gla, *w_po, *w_go, *w_out, *g_final;
    float* out; unsigned char* ws;
};

typedef __bf16 bf16x2_t __attribute__((ext_vector_type(2)));
typedef float f32x2_t __attribute__((ext_vector_type(2)));
__device__ __forceinline__ unsigned cvt_pk_bf16(float lo, float hi) { const f32x2_t f = {lo, hi}; const bf16x2_t b = __builtin_convertvector(f, bf16x2_t); return __builtin_bit_cast(unsigned, b); }
__device__ __forceinline__ float bf_lo(unsigned u) { return __uint_as_float(u << 16); }
__device__ __forceinline__ float bf_hi(unsigned u) { return __uint_as_float(u & 0xffff0000u); }
__device__ __forceinline__ float bf1(bf16_t b) { return __uint_as_float(((unsigned)b) << 16); }
__device__ __forceinline__ float wave_sum(float v) {
#pragma unroll
    for (int o = 1; o < 64; o <<= 1) v += __shfl_xor(v, o);
    return v;
}
__device__ __forceinline__ float sigmoid_f(float x) { return __builtin_amdgcn_rcpf(1.0f + __expf(-x)); }
__device__ __forceinline__ float silu_f(float x) { return x * sigmoid_f(x); }
#define LDS_WAIT() asm volatile("s_waitcnt lgkmcnt(0)" ::: "memory")
__device__ __forceinline__ int fresh_tid() { int t = threadIdx.x; asm volatile("" : "+v"(t)); return t; }

namespace pg8 {
constexpr int BM = 256, BK = 64, HALF = 128, HTB = HALF * BK * 2, STAGE_BYTES = 8 * HTB, NXCD = 8, WGM = 8;
__device__ __forceinline__ int lds_byte(int r, int c) { const int st = (r >> 4) * 2 + (c >> 5), rr = r & 15, cc = c & 31, ob = rr * 64 + cc * 2; return st * 1024 + (ob ^ (((ob >> 9) & 1) << 5)); }
__device__ __forceinline__ void stage_rc(int b, int& R, int& C) { const int st = b / 1024, sb = b % 1024, swz = sb ^ (((sb >> 9) & 1) << 5); R = (st >> 1) * 16 + swz / 64; C = (st & 1) * 32 + (swz % 64) / 2; }
__device__ __forceinline__ int perm32(int rho) { const int n = rho >> 4, i = rho & 15; return 8 * (i >> 2) + 4 * n + (i & 3); }
struct Unit { int pm, pn; };
struct Gemm { const bf16_t* A; const bf16_t* Bt; int lda, ldb, K, a_pn_off; };
struct StaticOrder {
    int nM, nN, nwg, G, c;
    __device__ void init(int M, int N, int G_, int c_) { nM = M / BM; nN = N / BM; nwg = nM * nN; G = G_; c = c_; }
    __device__ bool next(int i, Unit& u) const {
        const long L = (long)i * G + c; if (L >= nwg) return false;
        int wgid = (int)L; { const int q = nwg / NXCD, r = nwg % NXCD, xcd = wgid % NXCD, off = wgid / NXCD; wgid = (xcd < r ? xcd * (q + 1) : r * (q + 1) + (xcd - r) * q) + off; }
        const int nig = WGM * nN, gid = wgid / nig, fm = gid * WGM, gsz = (nM - fm) < WGM ? (nM - fm) : WGM;
        u.pm = fm + ((wgid % nig) % gsz); u.pn = (wgid % nig) / gsz; return true;
    }
};

template <class Epi>
__device__ __forceinline__ void gemm_phase(LAS unsigned char* lds, const Gemm g, const StaticOrder& S, const Epi& E) {
    const int tid = fresh_tid(), wid = __builtin_amdgcn_readfirstlane(tid >> 6), lane = tid & 63, wr = wid >> 2, wc = wid & 3, fr = lane & 15, fq = lane >> 4;
    int nt = g.K / BK; asm volatile("" : "+s"(nt));
    unsigned voffA[2], voffB[2];
#pragma unroll
    for (int i = 0; i < 2; ++i) { int R, C; stage_rc(tid * 16 + i * 8192, R, C); const int Rb = Epi::PERM ? ((R & ~31) + perm32(R & 31)) : R;
        voffA[i] = (unsigned)(R * g.lda + C) * 2u; voffB[i] = (unsigned)(Rb * g.ldb + C) * 2u; }
    const size_t kstep = (size_t)(BK * 2);
    const size_t hA = (size_t)HALF * g.lda * 2, hB = (size_t)HALF * g.ldb * 2;
    const size_t tA = 2 * hA, tB = 2 * hB;
    const unsigned ldsw = (unsigned)wid * 1024u;
    const int aoff = lds_byte(wr * 64 + fr, fq * 8), boff = lds_byte(wc * 32 + fr, fq * 8);
#define PG8_SA(b, h) (((b) * 2 + (h)) * HTB)
#define PG8_SB(b, h) ((4 + (b) * 2 + (h)) * HTB)
#define PG8_STAGE(bufoff, gbase, voff) do { _Pragma("unroll") for (int _i = 0; _i < 2; ++_i) \
        __builtin_amdgcn_global_load_lds((const unsigned*)((const char*)(gbase) + (voff)[_i]), (LAS unsigned*)(lds + (bufoff) + ldsw + _i * 8192), 16, 0, 0); } while (0)
#define PG8_LDA(dst, b, h) do { _Pragma("unroll") for (int m = 0; m < 4; ++m) _Pragma("unroll") for (int k = 0; k < 2; ++k) dst[m][k] = *(const LAS bf16x8*)(lds + PG8_SA(b, h) + aoff + m * 2048 + k * 1024); } while (0)
#define PG8_LDB(dst, b, h) do { _Pragma("unroll") for (int n = 0; n < 2; ++n) _Pragma("unroll") for (int k = 0; k < 2; ++k) dst[n][k] = *(const LAS bf16x8*)(lds + PG8_SB(b, h) + boff + n * 2048 + k * 1024); } while (0)
#define PG8_MMA(ai, bj, At, Bt) do { __builtin_amdgcn_s_setprio(1); _Pragma("unroll") for (int m = 0; m < 4; ++m) _Pragma("unroll") for (int n = 0; n < 2; ++n) _Pragma("unroll") for (int k = 0; k < 2; ++k) \
        acc[ai][bj][m][n] = __builtin_amdgcn_mfma_f32_16x16x32_bf16(Bt[n][k], At[m][k], acc[ai][bj][m][n], 0, 0, 0); __builtin_amdgcn_s_setprio(0); } while (0)
#define PG8_WAIT_V(n) asm volatile("s_waitcnt vmcnt(" #n ")" ::: "memory")
#define PG8_WAIT_L(n) asm volatile("s_waitcnt lgkmcnt(" #n ")" ::: "memory")
#define PG8_BAR __builtin_amdgcn_s_barrier()
#define PG8_SCHED __builtin_amdgcn_sched_barrier(0)
    Unit cur, nxt; int ui = 0;
    if (!S.next(0, cur)) return;
    f32x4 acc[2][2][4][2];
#pragma unroll
    for (int a = 0; a < 2; ++a)
#pragma unroll
        for (int b = 0; b < 2; ++b)
#pragma unroll
            for (int m = 0; m < 4; ++m)
#pragma unroll
                for (int n = 0; n < 2; ++n) acc[a][b][m][n] = (f32x4){0.f, 0.f, 0.f, 0.f};
    bf16x8 At[4][2], B0[2][2], B1[2][2];
    const char* cA = (const char*)g.A + (size_t)cur.pm * tA + (size_t)cur.pn * g.a_pn_off; const char* cB = (const char*)g.Bt + (size_t)cur.pn * tB;
    PG8_STAGE(PG8_SB(0, 0), cB, voffB); PG8_STAGE(PG8_SA(0, 0), cA, voffA); PG8_STAGE(PG8_SB(0, 1), cB + hB, voffB); PG8_STAGE(PG8_SA(0, 1), cA + hA, voffA);
    if (wr == 1) PG8_BAR;
    PG8_WAIT_V(4); PG8_BAR;
    PG8_STAGE(PG8_SB(1, 0), cB + kstep, voffB); PG8_STAGE(PG8_SA(1, 0), cA + kstep, voffA); PG8_STAGE(PG8_SB(1, 1), cB + hB + kstep, voffB);
    PG8_WAIT_V(6); PG8_BAR;
    for (;;) {
        const bool has_next = S.next(ui + 1, nxt);
        const char* nA = has_next ? (const char*)g.A + (size_t)nxt.pm * tA + (size_t)nxt.pn * g.a_pn_off : cA; const char* nB = has_next ? (const char*)g.Bt + (size_t)nxt.pn * tB : cB;
        for (int t = 0; t < nt; t += 2) {
            const bool last = (t == nt - 2);
            const char* a1 = cA + (size_t)(t + 1) * kstep;
            const char* a2 = last ? nA : cA + (size_t)(t + 2) * kstep; const char* b2 = last ? nB : cB + (size_t)(t + 2) * kstep;
            const char* a3 = a2 + kstep; const char* b3 = b2 + kstep;
            PG8_LDB(B0, 0, 0); PG8_SCHED; PG8_LDA(At, 0, 0); PG8_STAGE(PG8_SA(1, 1), a1 + hA, voffA);
            PG8_WAIT_L(8); PG8_BAR; PG8_WAIT_L(0); PG8_MMA(0, 0, At, B0); PG8_BAR; PG8_SCHED;
            PG8_LDB(B1, 0, 1); PG8_STAGE(PG8_SB(0, 0), b2, voffB);
            PG8_BAR; PG8_WAIT_L(0); PG8_MMA(0, 1, At, B1); PG8_BAR;
            PG8_LDA(At, 0, 1); PG8_STAGE(PG8_SA(0, 0), a2, voffA);
            PG8_BAR; PG8_WAIT_L(0); PG8_MMA(1, 0, At, B0); PG8_BAR; PG8_SCHED;
            PG8_STAGE(PG8_SB(0, 1), b2 + hB, voffB);
            PG8_WAIT_V(6); PG8_BAR; PG8_MMA(1, 1, At, B1); PG8_BAR;
            PG8_LDB(B0, 1, 0); PG8_SCHED; PG8_LDA(At, 1, 0); PG8_STAGE(PG8_SA(0, 1), a2 + hA, voffA);
            PG8_WAIT_L(8); PG8_BAR; PG8_WAIT_L(0); PG8_MMA(0, 0, At, B0); PG8_BAR; PG8_SCHED;
            PG8_LDB(B1, 1, 1); PG8_STAGE(PG8_SB(1, 0), b3, voffB);
            PG8_BAR; PG8_WAIT_L(0); PG8_MMA(0, 1, At, B1); PG8_BAR;
            PG8_LDA(At, 1, 1); PG8_STAGE(PG8_SA(1, 0), a3, voffA);
            PG8_BAR; PG8_WAIT_L(0); PG8_MMA(1, 0, At, B0); PG8_BAR; PG8_SCHED;
            PG8_STAGE(PG8_SB(1, 1), b3 + hB, voffB);
            PG8_WAIT_V(6); PG8_BAR; PG8_MMA(1, 1, At, B1); PG8_BAR;
        }
        E(acc, cur, wr, wc, fr, fq);
        if (!has_next) break;
#pragma unroll
        for (int a = 0; a < 2; ++a)
#pragma unroll
            for (int b = 0; b < 2; ++b)
#pragma unroll
                for (int m = 0; m < 4; ++m)
#pragma unroll
                    for (int n = 0; n < 2; ++n) acc[a][b][m][n] = (f32x4){0.f, 0.f, 0.f, 0.f};
        cur = nxt; cA = nA; cB = nB; ++ui;
    }
    PG8_WAIT_V(0);
    if (wr == 0) PG8_BAR;
    PG8_BAR;
#undef PG8_SA
#undef PG8_SB
#undef PG8_STAGE
#undef PG8_LDA
#undef PG8_LDB
#undef PG8_MMA
#undef PG8_WAIT_V
#undef PG8_WAIT_L
#undef PG8_BAR
#undef PG8_SCHED
}
}

typedef f32x4 AccT[2][2][4][2];
__device__ __forceinline__ u32x4 pack8(f32x4 v0, f32x4 v1) { u32x4 w; w.x = cvt_pk_bf16(v0[0], v0[1]); w.y = cvt_pk_bf16(v0[2], v0[3]); w.z = cvt_pk_bf16(v1[0], v1[1]); w.w = cvt_pk_bf16(v1[2], v1[3]); return w; }
__device__ __forceinline__ void unpack8(u32x4 w, f32x4& v0, f32x4& v1) { v0 = (f32x4){bf_lo(w.x), bf_hi(w.x), bf_lo(w.y), bf_hi(w.y)}; v1 = (f32x4){bf_lo(w.z), bf_hi(w.z), bf_lo(w.w), bf_hi(w.w)}; }

struct EpiZ {
    static constexpr bool PERM = true;
    bf16_t* Z;
    template <int ACT> __device__ __forceinline__ void run(const AccT& acc, const pg8::Unit& u, int, int, int, int) const {
        const int t_ = fresh_tid(), l_ = t_ & 63, w_ = __builtin_amdgcn_readfirstlane(t_ >> 6), wr = w_ >> 2, wc = w_ & 3, fr = l_ & 15, fq = l_ >> 4;
        const int row0 = u.pm * 256 + wr * 64 + fr, col0 = u.pn * 256 + wc * 32 + 8 * fq;
#pragma unroll
        for (int ai = 0; ai < 2; ++ai)
#pragma unroll
            for (int m = 0; m < 4; ++m) { bf16_t* rowp = Z + (size_t)(row0 + ai * 128 + m * 16) * ZLD + col0;
#pragma unroll
                for (int bj = 0; bj < 2; ++bj) { f32x4 v0 = acc[ai][bj][m][0], v1 = acc[ai][bj][m][1];
                    if (ACT == 1) {
#pragma unroll
                        for (int j = 0; j < 4; ++j) { v0[j] = silu_f(v0[j]); v1[j] = silu_f(v1[j]); } }
                    if (ACT == 2) {
#pragma unroll
                        for (int j = 0; j < 4; ++j) { v0[j] = sigmoid_f(v0[j]); v1[j] = sigmoid_f(v1[j]); } }
                    *(u32x4*)(rowp + bj * 128) = pack8(v0, v1); } }
    }
    __device__ __forceinline__ void operator()(const AccT& acc, const pg8::Unit& u, int wr, int wc, int fr, int fq) const {
        const int pn = u.pn;
        if ((pn >= 4 && pn < 8) || (pn >= 16 && pn < 20)) run<1>(acc, u, wr, wc, fr, fq);
        else if (pn >= 20) run<2>(acc, u, wr, wc, fr, fq);
        else run<0>(acc, u, wr, wc, fr, fq);
    }
};
struct EpiPool {
    static constexpr bool PERM = true;
    bf16_t* Z; const float* pool_scale;
    __device__ __forceinline__ void operator()(const AccT& acc, const pg8::Unit& u, int, int, int, int) const {
        const int t_ = fresh_tid(), l_ = t_ & 63, w_ = __builtin_amdgcn_readfirstlane(t_ >> 6), wr = w_ >> 2, wc = w_ & 3, fr = l_ & 15, fq = l_ >> 4;
        const int row0 = u.pm * 256 + wr * 64 + fr, col0 = u.pn * 256 + wc * 32 + 8 * fq;
#pragma unroll
        for (int bj = 0; bj < 2; ++bj) { const f32x4 s0 = *(const f32x4*)(pool_scale + col0 + bj * 128), s1 = *(const f32x4*)(pool_scale + col0 + bj * 128 + 4);
#pragma unroll
            for (int ai = 0; ai < 2; ++ai)
#pragma unroll
                for (int m = 0; m < 4; ++m) { bf16_t* rowp = Z + (size_t)(row0 + ai * 128 + m * 16) * ZLD + col0 + bj * 128;
                    f32x4 g0, g1; unpack8(*(const u32x4*)(rowp + ZC_SPG), g0, g1);
                    *(u32x4*)(rowp + ZC_YPOOL) = pack8(acc[ai][bj][m][0] * s0 * g0, acc[ai][bj][m][1] * s1 * g1);
                    if (m & 1) asm volatile("" ::: "memory"); } }
    }
};
struct EpiT {
    static constexpr bool PERM = true;
    bf16_t* Z;
    __device__ __forceinline__ void operator()(const AccT& acc, const pg8::Unit& u, int, int, int, int) const {
        const int t_ = fresh_tid(), l_ = t_ & 63, w_ = __builtin_amdgcn_readfirstlane(t_ >> 6), wr = w_ >> 2, wc = w_ & 3, fr = l_ & 15, fq = l_ >> 4;
        const int row0 = u.pm * 256 + wr * 64 + fr, col0 = u.pn * 256 + wc * 32 + 8 * fq;
#pragma unroll
        for (int ai = 0; ai < 2; ++ai)
#pragma unroll
            for (int m = 0; m < 4; ++m)
#pragma unroll
                for (int bj = 0; bj < 2; ++bj) { bf16_t* rowp = Z + (size_t)(row0 + ai * 128 + m * 16) * ZLD + col0 + bj * 128;
                    f32x4 g0, g1; unpack8(*(const u32x4*)(rowp + ZC_SMP), g0, g1);
                    *(u32x4*)(rowp + ZC_T) = pack8(acc[ai][bj][m][0] * g0, acc[ai][bj][m][1] * g1);
                    if (bj) asm volatile("" ::: "memory"); }
    }
};
struct EpiMerge {
    static constexpr bool PERM = true;
    bf16_t* Z;
    __device__ __forceinline__ void operator()(const AccT& acc, const pg8::Unit& u, int, int, int, int) const {
        const int t_ = fresh_tid(), l_ = t_ & 63, w_ = __builtin_amdgcn_readfirstlane(t_ >> 6), wr = w_ >> 2, wc = w_ & 3, fr = l_ & 15, fq = l_ >> 4;
        const int row0 = u.pm * 256 + wr * 64 + fr, col0 = u.pn * 256 + wc * 32 + 8 * fq;
#pragma unroll
        for (int ai = 0; ai < 2; ++ai)
#pragma unroll
            for (int m = 0; m < 4; ++m)
#pragma unroll
                for (int bj = 0; bj < 2; ++bj) { bf16_t* rowp = Z + (size_t)(row0 + ai * 128 + m * 16) * ZLD + col0 + bj * 128;
                    f32x4 g0, g1, t0, t1; unpack8(*(const u32x4*)(rowp + ZC_SMG), g0, g1); unpack8(*(const u32x4*)(rowp + ZC_T), t0, t1);
                    *(u32x4*)(rowp + ZC_MERGED) = pack8(t0 + acc[ai][bj][m][0] * g0, t1 + acc[ai][bj][m][1] * g1);
                    if (bj) asm volatile("" ::: "memory"); }
    }
};
struct EpiOut {
    static constexpr bool PERM = false;
    const float* x; const float* mod; float* out;
    __device__ __forceinline__ void operator()(const AccT& acc, const pg8::Unit& u, int, int, int, int) const {
        const int t_ = fresh_tid(), l_ = t_ & 63, w_ = __builtin_amdgcn_readfirstlane(t_ >> 6), wr = w_ >> 2, wc = w_ & 3, fr = l_ & 15, fq = l_ >> 4;
        const int row0 = u.pm * 256 + wr * 64 + fr, col0 = u.pn * 256 + wc * 32 + 4 * fq;
        const float* gate = mod + (size_t)(u.pm >> 4) * 3072 + 2048 + col0;
        f32x4 gv[2][2];
#pragma unroll
        for (int bj = 0; bj < 2; ++bj)
#pragma unroll
            for (int n = 0; n < 2; ++n) gv[bj][n] = *(const f32x4*)(gate + bj * 128 + n * 16);
#pragma unroll
        for (int ai = 0; ai < 2; ++ai)
#pragma unroll
            for (int m = 0; m < 4; ++m) { const size_t off = (size_t)(row0 + ai * 128 + m * 16) * DM + col0;
#pragma unroll
                for (int bj = 0; bj < 2; ++bj)
#pragma unroll
                    for (int n = 0; n < 2; ++n) { const f32x4 xv = *(const f32x4*)(x + off + bj * 128 + n * 16);
                        *(f32x4*)(out + off + bj * 128 + n * 16) = xv + gv[bj][n] * acc[ai][bj][m][n]; } }
    }
};

__device__ __forceinline__ void tr_item(const float* W, int ldw, int K, bf16_t* WT, int row_off, float* scr, int kb, int nb, int lane) {
    const int k0 = 64 * kb, n0 = 32 * nb;
#pragma unroll 8
    for (int i = 0; i < 32; ++i) { const int kk = 2 * i + (lane >> 5); scr[kk * 33 + (lane & 31)] = W[(size_t)(k0 + kk) * ldw + n0 + (lane & 31)]; }
    LDS_WAIT();
    const int c = lane & 7;
#pragma unroll
    for (int j = 0; j < 4; ++j) { const int n = (lane >> 3) + 8 * j; const float* s = scr + (8 * c) * 33 + n;
        u32x4 o; o.x = cvt_pk_bf16(s[0 * 33], s[1 * 33]); o.y = cvt_pk_bf16(s[2 * 33], s[3 * 33]); o.z = cvt_pk_bf16(s[4 * 33], s[5 * 33]); o.w = cvt_pk_bf16(s[6 * 33], s[7 * 33]);
        *(u32x4*)(WT + (size_t)(row_off + n0 + n) * K + k0 + 8 * c) = o; }
    LDS_WAIT();
}
__device__ __forceinline__ void phase0(const Params& p, unsigned char* shm) {
    const int tid = fresh_tid(), lane = tid & 63, wave = __builtin_amdgcn_readfirstlane(tid >> 6);
    float* mod = (float*)(p.ws + WS_MOD);
    if (blockIdx.x < 192) {
        float* sc = (float*)shm; float* red = (float*)(shm + 32768);
        for (int i = tid; i < 8192; i += 512) sc[i] = silu_f(p.c[i]);
        __syncthreads();
        const int col = tid & 15, ks = tid >> 4, n = blockIdx.x * 16 + col;
        float a[8];
#pragma unroll
        for (int b = 0; b < 8; ++b) a[b] = 0.f;
#pragma unroll 4
        for (int kk = 0; kk < 32; ++kk) { const int k = ks * 32 + kk; const float w = p.w_ada[(size_t)k * 3072 + n];
#pragma unroll
            for (int b = 0; b < 8; ++b) a[b] += sc[b * 1024 + k] * w; }
#pragma unroll
        for (int b = 0; b < 8; ++b) red[(ks * 8 + b) * 16 + col] = a[b];
        __syncthreads();
        if (tid < 128) { const int b = tid >> 4, cc = tid & 15, nn = blockIdx.x * 16 + cc; float s = p.b_ada[nn];
            for (int k2 = 0; k2 < 32; ++k2) s += red[(k2 * 8 + b) * 16 + cc];
            mod[b * 3072 + nn] = s; }
        __syncthreads();
    }
    float* scr = (float*)(shm + wave * 8448);
    const int gw = blockIdx.x * 8 + wave, NGW = gridDim.x * 8;
    bf16_t* WinT = (bf16_t*)(p.ws + WS_WINT); bf16_t* WpgT = (bf16_t*)(p.ws + WS_WPGT);
    bf16_t* WpoT = (bf16_t*)(p.ws + WS_WPOT); bf16_t* WgoT = (bf16_t*)(p.ws + WS_WGOT); bf16_t* WoT = (bf16_t*)(p.ws + WS_WOT);
    constexpr int I1 = 16 * 160, I2 = 16 * 64, I3 = 4 * 4 * 8, I4 = 16 * 32;
    for (int it = gw; it < I1 + I2 + I3 + 3 * I4; it += NGW) {
        int r = it;
        if (r < I1) { tr_item(p.w_in, INW, 1024, WinT, 0, scr, r / 160, r % 160, lane); continue; } r -= I1;
        if (r < I2) { tr_item(p.w_in + 5136, INW, 1024, WinT, 5120, scr, r / 64, r % 64, lane); continue; } r -= I2;
        if (r < I3) { const int g = r >> 5, q = r & 31; tr_item(p.w_pg + (size_t)g * 65536, 256, 256, WpgT, g * 256, scr, q >> 3, q & 7, lane); continue; } r -= I3;
        if (r < I4) { tr_item(p.w_po, 1024, 1024, WpoT, 0, scr, r >> 5, r & 31, lane); continue; } r -= I4;
        if (r < I4) { tr_item(p.w_go, 1024, 1024, WgoT, 0, scr, r >> 5, r & 31, lane); continue; } r -= I4;
        tr_item(p.w_out, 1024, 1024, WoT, 0, scr, r >> 5, r & 31, lane);
    }
}

__device__ __forceinline__ void phase1(const Params& p, unsigned char* shm, int vid) {
    const int tid = fresh_tid(), lane = tid & 63, wave = __builtin_amdgcn_readfirstlane(tid >> 6);
    float* WA = (float*)shm;
    for (int i = tid; i < 16384; i += 512) { const int k = i >> 4, r = i & 15; WA[(((k & 3) << 8) + (k >> 2)) * 16 + r] = p.w_in[(size_t)k * INW + 5120 + r]; }
    __syncthreads();
    const float* mod = (const float*)(p.ws + WS_MOD);
    bf16_t* H = (bf16_t*)((unsigned char*)p.out + DO_H); float* ALOW = (float*)(p.ws + WS_ALOW);
    for (int kr = 0; kr < 16; ++kr) {
        const int row = (vid & 7) * SEQ + (vid >> 3) * 8 + wave + 256 * kr;
        const int b = row >> 12;
        const f32x4* xr = (const f32x4*)(p.x + (size_t)row * DM) + lane;
        f32x4 v[4]; float s = 0.f;
#pragma unroll
        for (int j = 0; j < 4; ++j) { v[j] = xr[64 * j]; s += (v[j][0] * v[j][0] + v[j][1] * v[j][1]) + (v[j][2] * v[j][2] + v[j][3] * v[j][3]); }
        const float rstd = 1.0f / sqrtf(wave_sum(s) * (1.f / DM) + EPSV);
        float acc[16];
#pragma unroll
        for (int r = 0; r < 16; ++r) acc[r] = 0.f;
#pragma unroll
        for (int j = 0; j < 4; ++j) { const int k = 4 * lane + 256 * j;
            const f32x4 g4 = *(const f32x4*)(p.g_norm + k), sh = *(const f32x4*)(mod + b * 3072 + k), sc = *(const f32x4*)(mod + b * 3072 + 1024 + k);
            const f32x4 h = v[j] * rstd * g4 * (sc + 1.0f) + sh;
            u32x2 w; w.x = cvt_pk_bf16(h[0], h[1]); w.y = cvt_pk_bf16(h[2], h[3]);
            *(u32x2*)(H + (size_t)row * DM + k) = w;
#pragma unroll
            for (int e = 0; e < 4; ++e) { const f32x4* wp = (const f32x4*)(WA + (e * 256 + lane + 64 * j) * 16);
#pragma unroll
                for (int q = 0; q < 4; ++q) { const f32x4 wv = wp[q];
                    acc[4 * q + 0] += h[e] * wv[0]; acc[4 * q + 1] += h[e] * wv[1]; acc[4 * q + 2] += h[e] * wv[2]; acc[4 * q + 3] += h[e] * wv[3]; }
                asm volatile("" ::: "memory"); } }
        float outv = 0.f;
#pragma unroll
        for (int r = 0; r < 16; ++r) { const float t = wave_sum(acc[r]); if (lane == r) outv = t; }
        if (lane < 16) ALOW[(size_t)row * 16 + lane] = outv;
    }
}

constexpr int QP = 136;
__device__ __forceinline__ void phase3(const Params& p, unsigned char* shm, int vid) {
    const int tid = fresh_tid(), lane = tid & 63, wave = __builtin_amdgcn_readfirstlane(tid >> 6);
    bf16_t* qd_s = (bf16_t*)shm; bf16_t* ki_s = (bf16_t*)(shm + 64 * QP * 2);
    float* al_s = (float*)(shm + 2 * 64 * QP * 2); float* gsum = al_s + 1024;
    const bf16_t* Z = (const bf16_t*)(p.ws + WS_Z); const float* ALOW = (const float*)(p.ws + WS_ALOW);
    bf16_t* QD = (bf16_t*)((unsigned char*)p.out + DO_QD); bf16_t* KET = (bf16_t*)((unsigned char*)p.out + DO_KET);
    bf16_t* PG = (bf16_t*)(p.ws + WS_PG); float* DEC = (float*)(p.ws + WS_DEC);
    const int d = tid & 127, tg = tid >> 7;
    for (int ku = 0; ku < 8; ++ku) {
        const int u = (vid & 7) * 256 + (vid >> 3) + 32 * ku;
        const int bh = u >> 6, n = u & 63, b = bh >> 2, h = bh & 3; const int row0 = b * SEQ + n * 64;
        if (tid < 256) *(f32x4*)(al_s + tid * 4) = *(const f32x4*)(ALOW + (size_t)row0 * 16 + tid * 4);
        float wup[16];
#pragma unroll
        for (int r = 0; r < 16; ++r) wup[r] = p.w_up[r * 512 + h * 128 + d];
        const float ba = p.b_alpha[h * 128 + d];
        __syncthreads();
        float bl[16]; float run = 0.f;
#pragma unroll
        for (int i = 0; i < 16; ++i) { const float* al = al_s + (tg * 16 + i) * 16; float xg = ba;
#pragma unroll
            for (int r = 0; r < 16; ++r) xg += al[r] * wup[r];
            const float ls = fminf(xg, 0.f) - __logf(1.0f + __expf(-fabsf(xg)));
            run += ls * 0.0625f; bl[i] = run; }
        gsum[tg * 128 + d] = run;
        __syncthreads();
        float prefix = 0.f, total = 0.f;
#pragma unroll
        for (int g2 = 0; g2 < 4; ++g2) { const float gs = gsum[g2 * 128 + d]; total += gs; if (g2 < tg) prefix += gs; }
        float kev[16];
#pragma unroll
        for (int i = 0; i < 16; ++i) { const int t = tg * 16 + i; const float bb = bl[i] + prefix;
            const float q = bf1(Z[(size_t)(row0 + t) * ZLD + ZC_Q + h * 128 + d]), k = bf1(Z[(size_t)(row0 + t) * ZLD + ZC_K + h * 128 + d]);
            const float qdv = q * 0.08838834764831845f * __expf(bb), kiv = k * __expf(-bb); kev[i] = k * __expf(total - bb);
            const unsigned pk = cvt_pk_bf16(qdv, kiv);
            qd_s[t * QP + d] = (bf16_t)(pk & 0xffffu); ki_s[t * QP + d] = (bf16_t)(pk >> 16);
            QD[(size_t)(row0 + t) * 512 + h * 128 + d] = (bf16_t)(pk & 0xffffu); }
        { u32x4 w0, w1;
          w0.x = cvt_pk_bf16(kev[0], kev[1]); w0.y = cvt_pk_bf16(kev[2], kev[3]); w0.z = cvt_pk_bf16(kev[4], kev[5]); w0.w = cvt_pk_bf16(kev[6], kev[7]);
          w1.x = cvt_pk_bf16(kev[8], kev[9]); w1.y = cvt_pk_bf16(kev[10], kev[11]); w1.z = cvt_pk_bf16(kev[12], kev[13]); w1.w = cvt_pk_bf16(kev[14], kev[15]);
          bf16_t* kp = KET + ((size_t)u * 128 + d) * 64 + tg * 16; *(u32x4*)kp = w0; *(u32x4*)(kp + 8) = w1; }
        if (tg == 0) DEC[u * 128 + d] = __expf(total);
        __syncthreads();
        const int it = wave >> 1, fr = lane & 15, fq = lane >> 4;
#pragma unroll
        for (int j2 = 0; j2 < 2; ++j2) { const int jt = (wave & 1) * 2 + j2; f32x4 acc = (f32x4){0.f, 0.f, 0.f, 0.f};
            if (jt <= it) {
#pragma unroll
                for (int kk = 0; kk < 4; ++kk) { const bf16x8 aq = *(const bf16x8*)(qd_s + (it * 16 + fr) * QP + kk * 32 + fq * 8), bk = *(const bf16x8*)(ki_s + (jt * 16 + fr) * QP + kk * 32 + fq * 8);
                    acc = __builtin_amdgcn_mfma_f32_16x16x32_bf16(bk, aq, acc, 0, 0, 0); } }
            const int i = it * 16 + fr, j0 = jt * 16 + fq * 4;
#pragma unroll
            for (int e = 0; e < 4; ++e) if (j0 + e > i) acc[e] = 0.f;
            u32x2 w; w.x = cvt_pk_bf16(acc[0], acc[1]); w.y = cvt_pk_bf16(acc[2], acc[3]);
            *(u32x2*)(PG + (size_t)u * 4096 + i * 64 + j0) = w; }
        __syncthreads();
    }
}

constexpr int VP = 72, SP = 136;
__device__ __forceinline__ void phase4(const Params& p, unsigned char* shm, int vid) {
    const int tid = fresh_tid(), lane = tid & 63, wave = __builtin_amdgcn_readfirstlane(tid >> 6);
    bf16_t* vT = (bf16_t*)shm;
    bf16_t* ST = (bf16_t*)(shm + 2 * 32 * VP * 2);
    bf16_t* Z = (bf16_t*)(p.ws + WS_Z);
    const bf16_t* QD = (const bf16_t*)((unsigned char*)p.out + DO_QD); const bf16_t* KET = (const bf16_t*)((unsigned char*)p.out + DO_KET);
    const bf16_t* PG = (const bf16_t*)(p.ws + WS_PG); const float* DEC = (const float*)(p.ws + WS_DEC);
    bf16_t* O = (bf16_t*)((unsigned char*)p.out + DO_O);
    const int fr = lane & 15, fq = lane >> 4, it = wave >> 1, ct = wave & 1, dt = wave;
    {
        const int b = vid & 7, h = vid >> 6, s = (vid >> 3) & 7, bh = b * 4 + h;
        for (int i = tid; i < 32 * SP; i += 512) ST[i] = 0;
        f32x4 sacc[2]; sacc[0] = (f32x4){0.f, 0.f, 0.f, 0.f}; sacc[1] = sacc[0];
        const int vj = tid >> 3, vc = (tid & 7) * 4;
        for (int n = 0; n < 64; ++n) {
            const int u = bh * 64 + n, row0 = b * SEQ + n * 64, buf = n & 1;
            bf16x8 Pf[2], Qf[4], Kf[2];
#pragma unroll
            for (int kk = 0; kk < 2; ++kk) Pf[kk] = *(const bf16x8*)(PG + (size_t)u * 4096 + (it * 16 + fr) * 64 + kk * 32 + fq * 8);
#pragma unroll
            for (int kk = 0; kk < 4; ++kk) Qf[kk] = *(const bf16x8*)(QD + (size_t)(row0 + it * 16 + fr) * 512 + h * 128 + kk * 32 + fq * 8);
#pragma unroll
            for (int kk = 0; kk < 2; ++kk) Kf[kk] = *(const bf16x8*)(KET + ((size_t)u * 128 + dt * 16 + fr) * 64 + kk * 32 + fq * 8);
            const f32x4 decv = *(const f32x4*)(DEC + u * 128 + dt * 16 + fq * 4);
            const u32x2 vv = *(const u32x2*)(Z + (size_t)(row0 + vj) * ZLD + ZC_V + h * 256 + s * 32 + vc);
            bf16_t* vb = vT + buf * 32 * VP;
            vb[(vc + 0) * VP + vj] = (bf16_t)(vv.x & 0xffffu); vb[(vc + 1) * VP + vj] = (bf16_t)(vv.x >> 16);
            vb[(vc + 2) * VP + vj] = (bf16_t)(vv.y & 0xffffu); vb[(vc + 3) * VP + vj] = (bf16_t)(vv.y >> 16);
            __syncthreads();
            bf16x8 Vf[2][2], Vo[2], Sf[4];
#pragma unroll
            for (int c2 = 0; c2 < 2; ++c2)
#pragma unroll
                for (int kk = 0; kk < 2; ++kk) Vf[c2][kk] = *(const bf16x8*)(vb + (c2 * 16 + fr) * VP + kk * 32 + fq * 8);
#pragma unroll
            for (int kk = 0; kk < 2; ++kk) Vo[kk] = *(const bf16x8*)(vb + (ct * 16 + fr) * VP + kk * 32 + fq * 8);
            const bf16_t* sb = ST + buf * 32 * SP;
#pragma unroll
            for (int kk = 0; kk < 4; ++kk) Sf[kk] = *(const bf16x8*)(sb + (ct * 16 + fr) * SP + kk * 32 + fq * 8);
            f32x4 oacc = (f32x4){0.f, 0.f, 0.f, 0.f};
#pragma unroll
            for (int kk = 0; kk < 2; ++kk) oacc = __builtin_amdgcn_mfma_f32_16x16x32_bf16(Vo[kk], Pf[kk], oacc, 0, 0, 0);
#pragma unroll
            for (int kk = 0; kk < 4; ++kk) oacc = __builtin_amdgcn_mfma_f32_16x16x32_bf16(Sf[kk], Qf[kk], oacc, 0, 0, 0);
            { u32x2 w; w.x = cvt_pk_bf16(oacc[0], oacc[1]); w.y = cvt_pk_bf16(oacc[2], oacc[3]);
              *(u32x2*)(O + (size_t)(row0 + it * 16 + fr) * 1024 + h * 256 + s * 32 + ct * 16 + fq * 4) = w; }
            bf16_t* sn = ST + (buf ^ 1) * 32 * SP;
#pragma unroll
            for (int c2 = 0; c2 < 2; ++c2) { sacc[c2] = sacc[c2] * decv;
#pragma unroll
                for (int kk = 0; kk < 2; ++kk) sacc[c2] = __builtin_amdgcn_mfma_f32_16x16x32_bf16(Kf[kk], Vf[c2][kk], sacc[c2], 0, 0, 0);
                u32x2 w; w.x = cvt_pk_bf16(sacc[c2][0], sacc[c2][1]); w.y = cvt_pk_bf16(sacc[c2][2], sacc[c2][3]);
                *(u32x2*)(sn + (c2 * 16 + fr) * SP + dt * 16 + fq * 4) = w; }
        }
        __syncthreads();
    }
    {
        const int item = (vid >> 3) * 512 + tid;
        const int cv = item & 127, b = vid & 7, t0 = (item >> 7) * 32, c = cv * 8, w = 2 << (cv >> 5);
        const bf16_t* src = Z + (size_t)b * SEQ * ZLD + ZC_PV + c; bf16_t* dst = Z + (size_t)b * SEQ * ZLD + ZC_POOLED + c;
        f32x4 s0 = (f32x4){0.f, 0.f, 0.f, 0.f}, s1 = s0;
        for (int j = 1; j <= w; ++j) { const int t = t0 - j; if (t >= 0) { f32x4 a0, a1; unpack8(*(const u32x4*)(src + (size_t)t * ZLD), a0, a1); s0 += a0; s1 += a1; } }
        for (int t = t0; t < t0 + 32; ++t) {
            f32x4 c0, c1; unpack8(*(const u32x4*)(src + (size_t)t * ZLD), c0, c1); s0 += c0; s1 += c1;
            if (t - w >= 0) { f32x4 a0, a1; unpack8(*(const u32x4*)(src + (size_t)(t - w) * ZLD), a0, a1); s0 -= a0; s1 -= a1; }
            const float inv = 1.0f / (float)((t + 1 < w) ? (t + 1) : w);
            *(u32x4*)(dst + (size_t)t * ZLD) = pack8(s0 * inv - c0, s1 * inv - c1);
        }
    }
}

__device__ __forceinline__ void phase5a(const Params& p, int vid) {
    const int tid = fresh_tid(), lane = tid & 63, wave = __builtin_amdgcn_readfirstlane(tid >> 6);
    bf16_t* Z = (bf16_t*)(p.ws + WS_Z); const bf16_t* O = (const bf16_t*)((unsigned char*)p.out + DO_O);
    for (int kr = 0; kr < 16; ++kr) {
        const int row = (vid & 7) * SEQ + (vid >> 3) * 8 + wave + 256 * kr;
#pragma unroll
        for (int j = 0; j < 2; ++j) { const int c = 8 * lane + 512 * j;
            f32x4 o0, o1; unpack8(*(const u32x4*)(O + (size_t)row * 1024 + c), o0, o1);
            float ss = (o0[0] * o0[0] + o0[1] * o0[1]) + (o0[2] * o0[2] + o0[3] * o0[3]) + (o1[0] * o1[0] + o1[1] * o1[1]) + (o1[2] * o1[2] + o1[3] * o1[3]);
#pragma unroll
            for (int of = 1; of < 32; of <<= 1) ss += __shfl_xor(ss, of);
            const float rstd = 1.0f / sqrtf(ss * (1.f / 256.f) + EPSV);
            const f32x4 g0 = *(const f32x4*)(p.g_gla + (c & 255)), g1 = *(const f32x4*)(p.g_gla + (c & 255) + 4);
            bf16_t* zp = Z + (size_t)row * ZLD + ZC_SGG + c;
            f32x4 s0, s1; unpack8(*(const u32x4*)zp, s0, s1);
            *(u32x4*)zp = pack8(o0 * rstd * g0 * s0, o1 * rstd * g1 * s1); }
    }
}
__device__ __forceinline__ void phase8(const Params& p, int vid) {
    const int tid = fresh_tid(), lane = tid & 63, wave = __builtin_amdgcn_readfirstlane(tid >> 6);
    for (int kr = 0; kr < 16; ++kr) {
        const int row = (vid & 7) * SEQ + (vid >> 3) * 8 + wave + 256 * kr;
        f32x4* yr = (f32x4*)(p.out + (size_t)row * DM) + lane;
        f32x4 v[4]; float s = 0.f;
#pragma unroll
        for (int j = 0; j < 4; ++j) { v[j] = yr[64 * j]; s += (v[j][0] * v[j][0] + v[j][1] * v[j][1]) + (v[j][2] * v[j][2] + v[j][3] * v[j][3]); }
        const float rstd = 1.0f / sqrtf(wave_sum(s) * (1.f / DM) + EPSV);
#pragma unroll
        for (int j = 0; j < 4; ++j) yr[64 * j] = v[j] * rstd * *(const f32x4*)(p.g_final + 4 * lane + 256 * j);
    }
}

#define GRID_SEAM() do { __builtin_amdgcn_fence(__ATOMIC_RELEASE, "agent"); asm volatile("s_waitcnt vmcnt(0) lgkmcnt(0)" ::: "memory"); __syncthreads(); \
    bar_epoch += 1u; \
    if (threadIdx.x == 0) { __hip_atomic_fetch_add(bar_ctr, 1u, __ATOMIC_RELEASE, __HIP_MEMORY_SCOPE_AGENT); \
        const unsigned target_ = bar_epoch * gridDim.x; \
        while (__hip_atomic_load(bar_ctr, __ATOMIC_RELAXED, __HIP_MEMORY_SCOPE_AGENT) < target_) __builtin_amdgcn_s_sleep(2); \
        __builtin_amdgcn_fence(__ATOMIC_ACQUIRE, "agent"); } \
    __syncthreads(); __builtin_amdgcn_fence(__ATOMIC_ACQUIRE, "agent"); asm volatile("s_waitcnt vmcnt(0)" ::: "memory"); } while (0)
__global__ void __launch_bounds__(512, 2) hybrid_fwd(Params p) {
    extern __shared__ __attribute__((aligned(16))) unsigned char shm[];
    cg::grid_group grid = cg::this_grid();
    const int tid0 = threadIdx.x;
    LAS unsigned char* lds = (LAS unsigned char*)shm;
    bf16_t* Z = (bf16_t*)(p.ws + WS_Z);
    const int G = gridDim.x;
    unsigned* bar_ctr = (unsigned*)(p.ws + WS_BAR); unsigned bar_epoch = 0u;
    unsigned* census = bar_ctr + 16;
    if (tid0 == 0) { const unsigned xcc = (unsigned)__builtin_amdgcn_s_getreg((3 << 11) | 20) & 0xFu;
        const unsigned ord = __hip_atomic_fetch_add(census + (xcc & 7u), 1u, __ATOMIC_RELAXED, __HIP_MEMORY_SCOPE_AGENT);
        ((unsigned*)shm)[0] = xcc & 7u; ((unsigned*)shm)[1] = ord; }
    __syncthreads();
    const unsigned my_xcc = (unsigned)__builtin_amdgcn_readfirstlane((int)((unsigned*)shm)[0]), my_ord = (unsigned)__builtin_amdgcn_readfirstlane((int)((unsigned*)shm)[1]);
    __syncthreads();
    grid.sync();

    phase0(p, shm);
    GRID_SEAM();
    int vid;
    {
        unsigned cnt[8];
#pragma unroll
        for (int x = 0; x < 8; ++x) cnt[x] = __hip_atomic_load(census + x, __ATOMIC_RELAXED, __HIP_MEMORY_SCOPE_AGENT);
        if (my_ord < 32u) vid = (int)(my_ord * 8u + my_xcc);
        else { unsigned k = my_ord - 32u;
#pragma unroll
            for (int x = 0; x < 8; ++x) if ((unsigned)x < my_xcc && cnt[x] > 32u) k += cnt[x] - 32u;
            vid = -1;
#pragma unroll
            for (int x = 0; x < 8; ++x) { const unsigned holes = cnt[x] < 32u ? 32u - cnt[x] : 0u;
                if (vid < 0) { if (k < holes) vid = (int)((cnt[x] + k) * 8u + (unsigned)x); else k -= holes; } }
            if (vid < 0) vid = (int)blockIdx.x; }
        vid = __builtin_amdgcn_readfirstlane(vid);
    }
    const int cid = vid;
    phase1(p, shm, vid);
    GRID_SEAM();
    {
        pg8::Gemm g{(const bf16_t*)((unsigned char*)p.out + DO_H), (const bf16_t*)(p.ws + WS_WINT), 1024, 1024, 1024, 0};
        pg8::StaticOrder S; S.init(MTOK, ZLD, G, cid); EpiZ E{Z};
        pg8::gemm_phase<EpiZ>(lds, g, S, E);
    }
    GRID_SEAM();
    phase3(p, shm, vid);
    GRID_SEAM();
    phase4(p, shm, vid);
    GRID_SEAM();
    phase5a(p, vid);
    {
        pg8::Gemm g{Z + ZC_POOLED, (const bf16_t*)(p.ws + WS_WPGT), ZLD, 256, 256, 512};
        pg8::StaticOrder S; S.init(MTOK, 1024, G, cid); EpiPool E{Z, p.pool_scale};
        pg8::gemm_phase<EpiPool>(lds, g, S, E);
    }
    GRID_SEAM();
    {
        pg8::Gemm g3{Z + ZC_YPOOL, (const bf16_t*)(p.ws + WS_WPOT), ZLD, 1024, 1024, 0};
        pg8::StaticOrder S; S.init(MTOK, 1024, G, cid); EpiT E3{Z};
        pg8::gemm_phase<EpiT>(lds, g3, S, E3);
        pg8::Gemm g4{Z + ZC_YGLA, (const bf16_t*)(p.ws + WS_WGOT), ZLD, 1024, 1024, 0};
        EpiMerge E4{Z};
        pg8::gemm_phase<EpiMerge>(lds, g4, S, E4);
    }
    GRID_SEAM();
    {
        pg8::Gemm g{Z + ZC_MERGED, (const bf16_t*)(p.ws + WS_WOT), ZLD, 1024, 1024, 0};
        pg8::StaticOrder S; S.init(MTOK, 1024, G, cid); EpiOut E{p.x, (const float*)(p.ws + WS_MOD), p.out};
        pg8::gemm_phase<EpiOut>(lds, g, S, E);
    }
    GRID_SEAM();
    phase8(p, vid);
}

extern "C" void kernel_launch(void* const* d_in, const int* in_sizes, int n_in, void* d_out, int out_size, void* d_ws, size_t ws_size, hipStream_t stream) {
    static int grid_blocks = 0;
    if (grid_blocks == 0) {
        if (ws_size < WS_END) { fprintf(stderr, "kernel_launch: workspace too small (%zu < %zu)\n", ws_size, (size_t)WS_END); grid_blocks = -1; return; }
        int dev = 0, cus = 0, per_cu = 0;
        hipGetDevice(&dev);
        hipDeviceGetAttribute(&cus, hipDeviceAttributeMultiprocessorCount, dev);
        if (hipFuncSetAttribute((const void*)hybrid_fwd, hipFuncAttributeMaxDynamicSharedMemorySize, LDS_BYTES) != hipSuccess) { fprintf(stderr, "kernel_launch: hipFuncSetAttribute failed\n"); grid_blocks = -1; return; }
        hipOccupancyMaxActiveBlocksPerMultiprocessor(&per_cu, (const void*)hybrid_fwd, 512, LDS_BYTES);
        if (per_cu < 1) per_cu = 1;
        grid_blocks = cus * per_cu;
        if (grid_blocks != 256) { fprintf(stderr, "kernel_launch: built for a 256-workgroup resident grid, got %d\n", grid_blocks); if (grid_blocks > 256) grid_blocks = 256; }
        (void)hipGetLastError();
    }
    if (grid_blocks < 0) return;
    Params p{};
    p.x = (const float*)d_in[0]; p.c = (const float*)d_in[1]; p.g_norm = (const float*)d_in[2]; p.w_ada = (const float*)d_in[3]; p.b_ada = (const float*)d_in[4];
    p.w_in = (const float*)d_in[5]; p.w_pg = (const float*)d_in[6]; p.pool_scale = (const float*)d_in[7]; p.w_up = (const float*)d_in[8]; p.b_alpha = (const float*)d_in[9];
    p.g_gla = (const float*)d_in[10]; p.w_po = (const float*)d_in[11]; p.w_go = (const float*)d_in[12]; p.w_out = (const float*)d_in[13]; p.g_final = (const float*)d_in[14];
    p.out = (float*)d_out; p.ws = (unsigned char*)d_ws;
    (void)hipMemsetAsync((unsigned char*)d_ws + WS_BAR, 0, 256, stream);
    void* args[] = {&p};
    hipError_t e = hipLaunchCooperativeKernel((const void*)hybrid_fwd, dim3(grid_blocks), dim3(512), args, LDS_BYTES, stream);
    if (e != hipSuccess) fprintf(stderr, "cooperative launch failed: %s (grid %d)\n", hipGetErrorString(e), grid_blocks);
}
```

```cpp
#include <hip/hip_runtime.h>
#include <hip/hip_cooperative_groups.h>
#include <cstdio>
namespace cg = cooperative_groups;

#define LAS __attribute__((address_space(3)))
typedef unsigned short bf16_t;
typedef short bf16x8 __attribute__((ext_vector_type(8)));
typedef float f32x4 __attribute__((ext_vector_type(4)));
typedef unsigned u32x4 __attribute__((ext_vector_type(4)));
typedef unsigned u32x2 __attribute__((ext_vector_type(2)));

constexpr int DM = 1024, NB = 8, SEQ = 4096, MTOK = NB * SEQ;
constexpr int INW = 7184, ZLD = 7168;
constexpr int ZC_PV = 0, ZC_SPG = 1024, ZC_Q = 2048, ZC_K = 2560, ZC_V = 3072, ZC_SGG = 4096, ZC_SMP = 5120, ZC_SMG = 6144;
constexpr int ZC_YPOOL = 0, ZC_MERGED = 1024, ZC_POOLED = 2048, ZC_T = 2048, ZC_YGLA = 4096;
constexpr float EPSV = 1e-6f;
constexpr size_t WS_Z = 0;
constexpr size_t WS_WINT = WS_Z + (size_t)MTOK * ZLD * 2;
constexpr size_t WS_WPGT = WS_WINT + (size_t)ZLD * 1024 * 2;
constexpr size_t WS_WPOT = WS_WPGT + (size_t)1024 * 256 * 2;
constexpr size_t WS_WGOT = WS_WPOT + (size_t)1024 * 1024 * 2;
constexpr size_t WS_WOT = WS_WGOT + (size_t)1024 * 1024 * 2;
constexpr size_t WS_MOD = WS_WOT + (size_t)1024 * 1024 * 2;
constexpr size_t WS_ALOW = WS_MOD + (size_t)8 * 3072 * 4;
constexpr size_t WS_PG = WS_ALOW + (size_t)MTOK * 16 * 4;
constexpr size_t WS_DEC = WS_PG + (size_t)2048 * 4096 * 2;
constexpr size_t WS_BAR = WS_DEC + (size_t)2048 * 128 * 4;
constexpr size_t WS_END = WS_BAR + 4096;
constexpr size_t DO_H = 0;
constexpr size_t DO_QD = 0;
constexpr size_t DO_KET = (size_t)MTOK * 512 * 2;
constexpr size_t DO_O = (size_t)MTOK * 1024 * 2;
constexpr int LDS_BYTES = 131072;

struct Params {
    const float *x, *c, *g_norm, *w_ada, *b_ada, *w_in, *w_pg, *pool_scale, *w_up, *b_alpha, *g_gla, *w_po, *w_go, *w_out, *g_final;
    float* out; unsigned char* ws;
};

typedef __bf16 bf16x2_t __attribute__((ext_vector_type(2)));
typedef float f32x2_t __attribute__((ext_vector_type(2)));
__device__ __forceinline__ unsigned cvt_pk_bf16(float lo, float hi) { const f32x2_t f = {lo, hi}; const bf16x2_t b = __builtin_convertvector(f, bf16x2_t); return __builtin_bit_cast(unsigned, b); }
__device__ __forceinline__ float bf_lo(unsigned u) { return __uint_as_float(u << 16); }
__device__ __forceinline__ float bf_hi(unsigned u) { return __uint_as_float(u & 0xffff0000u); }
__device__ __forceinline__ float bf1(bf16_t b) { return __uint_as_float(((unsigned)b) << 16); }
__device__ __forceinline__ float wave_sum(float v) {
#pragma unroll
    for (int o = 1; o < 64; o <<= 1) v += __shfl_xor(v, o);
    return v;
}
__device__ __forceinline__ float sigmoid_f(float x) { return __builtin_amdgcn_rcpf(1.0f + __expf(-x)); }
__device__ __forceinline__ float silu_f(float x) { return x * sigmoid_f(x); }
#define LDS_WAIT() asm volatile("s_waitcnt lgkmcnt(0)" ::: "memory")
__device__ __forceinline__ int fresh_tid() { int t = threadIdx.x; asm volatile("" : "+v"(t)); return t; }

namespace pg8 {
constexpr int BM = 256, BK = 64, HALF = 128, HTB = HALF * BK * 2, STAGE_BYTES = 8 * HTB, NXCD = 8, WGM = 8;
__device__ __forceinline__ int lds_byte(int r, int c) { const int st = (r >> 4) * 2 + (c >> 5), rr = r & 15, cc = c & 31, ob = rr * 64 + cc * 2; return st * 1024 + (ob ^ (((ob >> 9) & 1) << 5)); }
__device__ __forceinline__ void stage_rc(int b, int& R, int& C) { const int st = b / 1024, sb = b % 1024, swz = sb ^ (((sb >> 9) & 1) << 5); R = (st >> 1) * 16 + swz / 64; C = (st & 1) * 32 + (swz % 64) / 2; }
__device__ __forceinline__ int perm32(int rho) { const int n = rho >> 4, i = rho & 15; return 8 * (i >> 2) + 4 * n + (i & 3); }
struct Unit { int pm, pn; };
struct Gemm { const bf16_t* A; const bf16_t* Bt; int lda, ldb, K, a_pn_off; };
struct StaticOrder {
    int nM, nN, nwg, G, c;
    __device__ void init(int M, int N, int G_, int c_) { nM = M / BM; nN = N / BM; nwg = nM * nN; G = G_; c = c_; }
    __device__ bool next(int i, Unit& u) const {
        const long L = (long)i * G + c; if (L >= nwg) return false;
        int wgid = (int)L; { const int q = nwg / NXCD, r = nwg % NXCD, xcd = wgid % NXCD, off = wgid / NXCD; wgid = (xcd < r ? xcd * (q + 1) : r * (q + 1) + (xcd - r) * q) + off; }
        const int nig = WGM * nN, gid = wgid / nig, fm = gid * WGM, gsz = (nM - fm) < WGM ? (nM - fm) : WGM;
        u.pm = fm + ((wgid % nig) % gsz); u.pn = (wgid % nig) / gsz; return true;
    }
};

template <class Epi>
__device__ __forceinline__ void gemm_phase(LAS unsigned char* lds, const Gemm g, const StaticOrder& S, const Epi& E) {
    const int tid = fresh_tid(), wid = __builtin_amdgcn_readfirstlane(tid >> 6), lane = tid & 63, wr = wid >> 2, wc = wid & 3, fr = lane & 15, fq = lane >> 4;
    int nt = g.K / BK; asm volatile("" : "+s"(nt));
    unsigned voffA[2], voffB[2];
#pragma unroll
    for (int i = 0; i < 2; ++i) { int R, C; stage_rc(tid * 16 + i * 8192, R, C); const int Rb = Epi::PERM ? ((R & ~31) + perm32(R & 31)) : R;
        voffA[i] = (unsigned)(R * g.lda + C) * 2u; voffB[i] = (unsigned)(Rb * g.ldb + C) * 2u; }
    const size_t kstep = (size_t)(BK * 2);
    const size_t hA = (size_t)HALF * g.lda * 2, hB = (size_t)HALF * g.ldb * 2;
    const size_t tA = 2 * hA, tB = 2 * hB;
    const unsigned ldsw = (unsigned)wid * 1024u;
    const int aoff = lds_byte(wr * 64 + fr, fq * 8), boff = lds_byte(wc * 32 + fr, fq * 8);
#define PG8_SA(b, h) (((b) * 2 + (h)) * HTB)
#define PG8_SB(b, h) ((4 + (b) * 2 + (h)) * HTB)
#define PG8_STAGE(bufoff, gbase, voff) do { _Pragma("unroll") for (int _i = 0; _i < 2; ++_i) \
        __builtin_amdgcn_global_load_lds((const unsigned*)((const char*)(gbase) + (voff)[_i]), (LAS unsigned*)(lds + (bufoff) + ldsw + _i * 8192), 16, 0, 0); } while (0)
#define PG8_LDA(dst, b, h) do { _Pragma("unroll") for (int m = 0; m < 4; ++m) _Pragma("unroll") for (int k = 0; k < 2; ++k) dst[m][k] = *(const LAS bf16x8*)(lds + PG8_SA(b, h) + aoff + m * 2048 + k * 1024); } while (0)
#define PG8_LDB(dst, b, h) do { _Pragma("unroll") for (int n = 0; n < 2; ++n) _Pragma("unroll") for (int k = 0; k < 2; ++k) dst[n][k] = *(const LAS bf16x8*)(lds + PG8_SB(b, h) + boff + n * 2048 + k * 1024); } while (0)
#define PG8_MMA(ai, bj, At, Bt) do { __builtin_amdgcn_s_setprio(1); _Pragma("unroll") for (int m = 0; m < 4; ++m) _Pragma("unroll") for (int n = 0; n < 2; ++n) _Pragma("unroll") for (int k = 0; k < 2; ++k) \
        acc[ai][bj][m][n] = __builtin_amdgcn_mfma_f32_16x16x32_bf16(Bt[n][k], At[m][k], acc[ai][bj][m][n], 0, 0, 0); __builtin_amdgcn_s_setprio(0); } while (0)
#define PG8_WAIT_V(n) asm volatile("s_waitcnt vmcnt(" #n ")" ::: "memory")
#define PG8_WAIT_L(n) asm volatile("s_waitcnt lgkmcnt(" #n ")" ::: "memory")
#define PG8_BAR __builtin_amdgcn_s_barrier()
#define PG8_SCHED __builtin_amdgcn_sched_barrier(0)
    Unit cur, nxt; int ui = 0;
    if (!S.next(0, cur)) return;
    f32x4 acc[2][2][4][2];
#pragma unroll
    for (int a = 0; a < 2; ++a)
#pragma unroll
        for (int b = 0; b < 2; ++b)
#pragma unroll
            for (int m = 0; m < 4; ++m)
#pragma unroll
                for (int n = 0; n < 2; ++n) acc[a][b][m][n] = (f32x4){0.f, 0.f, 0.f, 0.f};
    bf16x8 At[4][2], B0[2][2], B1[2][2];
    const char* cA = (const char*)g.A + (size_t)cur.pm * tA + (size_t)cur.pn * g.a_pn_off; const char* cB = (const char*)g.Bt + (size_t)cur.pn * tB;
    PG8_STAGE(PG8_SB(0, 0), cB, voffB); PG8_STAGE(PG8_SA(0, 0), cA, voffA); PG8_STAGE(PG8_SB(0, 1), cB + hB, voffB); PG8_STAGE(PG8_SA(0, 1), cA + hA, voffA);
    if (wr == 1) PG8_BAR;
    PG8_WAIT_V(4); PG8_BAR;
    PG8_STAGE(PG8_SB(1, 0), cB + kstep, voffB); PG8_STAGE(PG8_SA(1, 0), cA + kstep, voffA); PG8_STAGE(PG8_SB(1, 1), cB + hB + kstep, voffB);
    PG8_WAIT_V(6); PG8_BAR;
    for (;;) {
        const bool has_next = S.next(ui + 1, nxt);
        const char* nA = has_next ? (const char*)g.A + (size_t)nxt.pm * tA + (size_t)nxt.pn * g.a_pn_off : cA; const char* nB = has_next ? (const char*)g.Bt + (size_t)nxt.pn * tB : cB;
        for (int t = 0; t < nt; t += 2) {
            const bool last = (t == nt - 2);
            const char* a1 = cA + (size_t)(t + 1) * kstep;
            const char* a2 = last ? nA : cA + (size_t)(t + 2) * kstep; const char* b2 = last ? nB : cB + (size_t)(t + 2) * kstep;
            const char* a3 = a2 + kstep; const char* b3 = b2 + kstep;
            PG8_LDB(B0, 0, 0); PG8_SCHED; PG8_LDA(At, 0, 0); PG8_STAGE(PG8_SA(1, 1), a1 + hA, voffA);
            PG8_WAIT_L(8); PG8_BAR; PG8_WAIT_L(0); PG8_MMA(0, 0, At, B0); PG8_BAR; PG8_SCHED;
            PG8_LDB(B1, 0, 1); PG8_STAGE(PG8_SB(0, 0), b2, voffB);
            PG8_BAR; PG8_WAIT_L(0); PG8_MMA(0, 1, At, B1); PG8_BAR;
            PG8_LDA(At, 0, 1); PG8_STAGE(PG8_SA(0, 0), a2, voffA);
            PG8_BAR; PG8_WAIT_L(0); PG8_MMA(1, 0, At, B0); PG8_BAR; PG8_SCHED;
            PG8_STAGE(PG8_SB(0, 1), b2 + hB, voffB);
            PG8_WAIT_V(6); PG8_BAR; PG8_MMA(1, 1, At, B1); PG8_BAR;
            PG8_LDB(B0, 1, 0); PG8_SCHED; PG8_LDA(At, 1, 0); PG8_STAGE(PG8_SA(0, 1), a2 + hA, voffA);
            PG8_WAIT_L(8); PG8_BAR; PG8_WAIT_L(0); PG8_MMA(0, 0, At, B0); PG8_BAR; PG8_SCHED;
            PG8_LDB(B1, 1, 1); PG8_STAGE(PG8_SB(1, 0), b3, voffB);
            PG8_BAR; PG8_WAIT_L(0); PG8_MMA(0, 1, At, B1); PG8_BAR;
            PG8_LDA(At, 1, 1); PG8_STAGE(PG8_SA(1, 0), a3, voffA);
            PG8_BAR; PG8_WAIT_L(0); PG8_MMA(1, 0, At, B0); PG8_BAR; PG8_SCHED;
            PG8_STAGE(PG8_SB(1, 1), b3 + hB, voffB);
            PG8_WAIT_V(6); PG8_BAR; PG8_MMA(1, 1, At, B1); PG8_BAR;
        }
        E(acc, cur, wr, wc, fr, fq);
        if (!has_next) break;
#pragma unroll
        for (int a = 0; a < 2; ++a)
#pragma unroll
            for (int b = 0; b < 2; ++b)
#pragma unroll
                for (int m = 0; m < 4; ++m)
#pragma unroll
                    for (int n = 0; n < 2; ++n) acc[a][b][m][n] = (f32x4){0.f, 0.f, 0.f, 0.f};
        cur = nxt; cA = nA; cB = nB; ++ui;
    }
    PG8_WAIT_V(0);
    if (wr == 0) PG8_BAR;
    PG8_BAR;
#undef PG8_SA
#undef PG8_SB
#undef PG8_STAGE
#undef PG8_LDA
#undef PG8_LDB
#undef PG8_MMA
#undef PG8_WAIT_V
#undef PG8_WAIT_L
#undef PG8_BAR
#undef PG8_SCHED
}
}

typedef f32x4 AccT[2][2][4][2];
__device__ __forceinline__ u32x4 pack8(f32x4 v0, f32x4 v1) { u32x4 w; w.x = cvt_pk_bf16(v0[0], v0[1]); w.y = cvt_pk_bf16(v0[2], v0[3]); w.z = cvt_pk_bf16(v1[0], v1[1]); w.w = cvt_pk_bf16(v1[2], v1[3]); return w; }
__device__ __forceinline__ void unpack8(u32x4 w, f32x4& v0, f32x4& v1) { v0 = (f32x4){bf_lo(w.x), bf_hi(w.x), bf_lo(w.y), bf_hi(w.y)}; v1 = (f32x4){bf_lo(w.z), bf_hi(w.z), bf_lo(w.w), bf_hi(w.w)}; }

struct EpiZ {
    static constexpr bool PERM = true;
    bf16_t* Z;
    template <int ACT> __device__ __forceinline__ void run(const AccT& acc, const pg8::Unit& u, int, int, int, int) const {
        const int t_ = fresh_tid(), l_ = t_ & 63, w_ = __builtin_amdgcn_readfirstlane(t_ >> 6), wr = w_ >> 2, wc = w_ & 3, fr = l_ & 15, fq = l_ >> 4;
        const int row0 = u.pm * 256 + wr * 64 + fr, col0 = u.pn * 256 + wc * 32 + 8 * fq;
#pragma unroll
        for (int ai = 0; ai < 2; ++ai)
#pragma unroll
            for (int m = 0; m < 4; ++m) { bf16_t* rowp = Z + (size_t)(row0 + ai * 128 + m * 16) * ZLD + col0;
#pragma unroll
                for (int bj = 0; bj < 2; ++bj) { f32x4 v0 = acc[ai][bj][m][0], v1 = acc[ai][bj][m][1];
                    if (ACT == 1) {
#pragma unroll
                        for (int j = 0; j < 4; ++j) { v0[j] = silu_f(v0[j]); v1[j] = silu_f(v1[j]); } }
                    if (ACT == 2) {
#pragma unroll
                        for (int j = 0; j < 4; ++j) { v0[j] = sigmoid_f(v0[j]); v1[j] = sigmoid_f(v1[j]); } }
                    *(u32x4*)(rowp + bj * 128) = pack8(v0, v1); } }
    }
    __device__ __forceinline__ void operator()(const AccT& acc, const pg8::Unit& u, int wr, int wc, int fr, int fq) const {
        const int pn = u.pn;
        if ((pn >= 4 && pn < 8) || (pn >= 16 && pn < 20)) run<1>(acc, u, wr, wc, fr, fq);
        else if (pn >= 20) run<2>(acc, u, wr, wc, fr, fq);
        else run<0>(acc, u, wr, wc, fr, fq);
    }
};
struct EpiPool {
    static constexpr bool PERM = true;
    bf16_t* Z; const float* pool_scale;
    __device__ __forceinline__ void operator()(const AccT& acc, const pg8::Unit& u, int, int, int, int) const {
        const int t_ = fresh_tid(), l_ = t_ & 63, w_ = __builtin_amdgcn_readfirstlane(t_ >> 6), wr = w_ >> 2, wc = w_ & 3, fr = l_ & 15, fq = l_ >> 4;
        const int row0 = u.pm * 256 + wr * 64 + fr, col0 = u.pn * 256 + wc * 32 + 8 * fq;
#pragma unroll
        for (int bj = 0; bj < 2; ++bj) { const f32x4 s0 = *(const f32x4*)(pool_scale + col0 + bj * 128), s1 = *(const f32x4*)(pool_scale + col0 + bj * 128 + 4);
#pragma unroll
            for (int ai = 0; ai < 2; ++ai)
#pragma unroll
                for (int m = 0; m < 4; ++m) { bf16_t* rowp = Z + (size_t)(row0 + ai * 128 + m * 16) * ZLD + col0 + bj * 128;
                    f32x4 g0, g1; unpack8(*(const u32x4*)(rowp + ZC_SPG), g0, g1);
                    *(u32x4*)(rowp + ZC_YPOOL) = pack8(acc[ai][bj][m][0] * s0 * g0, acc[ai][bj][m][1] * s1 * g1);
                    if (m & 1) asm volatile("" ::: "memory"); } }
    }
};
struct EpiT {
    static constexpr bool PERM = true;
    bf16_t* Z;
    __device__ __forceinline__ void operator()(const AccT& acc, const pg8::Unit& u, int, int, int, int) const {
        const int t_ = fresh_tid(), l_ = t_ & 63, w_ = __builtin_amdgcn_readfirstlane(t_ >> 6), wr = w_ >> 2, wc = w_ & 3, fr = l_ & 15, fq = l_ >> 4;
        const int row0 = u.pm * 256 + wr * 64 + fr, col0 = u.pn * 256 + wc * 32 + 8 * fq;
#pragma unroll
        for (int ai = 0; ai < 2; ++ai)
#pragma unroll
            for (int m = 0; m < 4; ++m)
#pragma unroll
                for (int bj = 0; bj < 2; ++bj) { bf16_t* rowp = Z + (size_t)(row0 + ai * 128 + m * 16) * ZLD + col0 + bj * 128;
                    f32x4 g0, g1; unpack8(*(const u32x4*)(rowp + ZC_SMP), g0, g1);
                    *(u32x4*)(rowp + ZC_T) = pack8(acc[ai][bj][m][0] * g0, acc[ai][bj][m][1] * g1);
                    if (bj) asm volatile("" ::: "memory"); }
    }
};
struct EpiMerge {
    static constexpr bool PERM = true;
    bf16_t* Z;
    __device__ __forceinline__ void operator()(const AccT& acc, const pg8::Unit& u, int, int, int, int) const {
        const int t_ = fresh_tid(), l_ = t_ & 63, w_ = __builtin_amdgcn_readfirstlane(t_ >> 6), wr = w_ >> 2, wc = w_ & 3, fr = l_ & 15, fq = l_ >> 4;
        const int row0 = u.pm * 256 + wr * 64 + fr, col0 = u.pn * 256 + wc * 32 + 8 * fq;
#pragma unroll
        for (int ai = 0; ai < 2; ++ai)
#pragma unroll
            for (int m = 0; m < 4; ++m)
#pragma unroll
                for (int bj = 0; bj < 2; ++bj) { bf16_t* rowp = Z + (size_t)(row0 + ai * 128 + m * 16) * ZLD + col0 + bj * 128;
                    f32x4 g0, g1, t0, t1; unpack8(*(const u32x4*)(rowp + ZC_SMG), g0, g1); unpack8(*(const u32x4*)(rowp + ZC_T), t0, t1);
                    *(u32x4*)(rowp + ZC_MERGED) = pack8(t0 + acc[ai][bj][m][0] * g0, t1 + acc[ai][bj][m][1] * g1);
                    if (bj) asm volatile("" ::: "memory"); }
    }
};
struct EpiOut {
    static constexpr bool PERM = false;
    const float* x; const float* mod; float* out;
    __device__ __forceinline__ void operator()(const AccT& acc, const pg8::Unit& u, int, int, int, int) const {
        const int t_ = fresh_tid(), l_ = t_ & 63, w_ = __builtin_amdgcn_readfirstlane(t_ >> 6), wr = w_ >> 2, wc = w_ & 3, fr = l_ & 15, fq = l_ >> 4;
        const int row0 = u.pm * 256 + wr * 64 + fr, col0 = u.pn * 256 + wc * 32 + 4 * fq;
        const float* gate = mod + (size_t)(u.pm >> 4) * 3072 + 2048 + col0;
        f32x4 gv[2][2];
#pragma unroll
        for (int bj = 0; bj < 2; ++bj)
#pragma unroll
            for (int n = 0; n < 2; ++n) gv[bj][n] = *(const f32x4*)(gate + bj * 128 + n * 16);
#pragma unroll
        for (int ai = 0; ai < 2; ++ai)
#pragma unroll
            for (int m = 0; m < 4; ++m) { const size_t off = (size_t)(row0 + ai * 128 + m * 16) * DM + col0;
#pragma unroll
                for (int bj = 0; bj < 2; ++bj)
#pragma unroll
                    for (int n = 0; n < 2; ++n) { const f32x4 xv = *(const f32x4*)(x + off + bj * 128 + n * 16);
                        *(f32x4*)(out + off + bj * 128 + n * 16) = xv + gv[bj][n] * acc[ai][bj][m][n]; } }
    }
};

__device__ __forceinline__ void tr_item(const float* W, int ldw, int K, bf16_t* WT, int row_off, float* scr, int kb, int nb, int lane) {
    const int k0 = 64 * kb, n0 = 32 * nb;
#pragma unroll 8
    for (int i = 0; i < 32; ++i) { const int kk = 2 * i + (lane >> 5); scr[kk * 33 + (lane & 31)] = W[(size_t)(k0 + kk) * ldw + n0 + (lane & 31)]; }
    LDS_WAIT();
    const int c = lane & 7;
#pragma unroll
    for (int j = 0; j < 4; ++j) { const int n = (lane >> 3) + 8 * j; const float* s = scr + (8 * c) * 33 + n;
        u32x4 o; o.x = cvt_pk_bf16(s[0 * 33], s[1 * 33]); o.y = cvt_pk_bf16(s[2 * 33], s[3 * 33]); o.z = cvt_pk_bf16(s[4 * 33], s[5 * 33]); o.w = cvt_pk_bf16(s[6 * 33], s[7 * 33]);
        *(u32x4*)(WT + (size_t)(row_off + n0 + n) * K + k0 + 8 * c) = o; }
    LDS_WAIT();
}
__device__ __forceinline__ void phase0(const Params& p, unsigned char* shm) {
    const int tid = fresh_tid(), lane = tid & 63, wave = __builtin_amdgcn_readfirstlane(tid >> 6);
    float* mod = (float*)(p.ws + WS_MOD);
    if (blockIdx.x < 192) {
        float* sc = (float*)shm; float* red = (float*)(shm + 32768);
        for (int i = tid; i < 8192; i += 512) sc[i] = silu_f(p.c[i]);
        __syncthreads();
        const int col = tid & 15, ks = tid >> 4, n = blockIdx.x * 16 + col;
        float a[8];
#pragma unroll
        for (int b = 0; b < 8; ++b) a[b] = 0.f;
#pragma unroll 4
        for (int kk = 0; kk < 32; ++kk) { const int k = ks * 32 + kk; const float w = p.w_ada[(size_t)k * 3072 + n];
#pragma unroll
            for (int b = 0; b < 8; ++b) a[b] += sc[b * 1024 + k] * w; }
#pragma unroll
        for (int b = 0; b < 8; ++b) red[(ks * 8 + b) * 16 + col] = a[b];
        __syncthreads();
        if (tid < 128) { const int b = tid >> 4, cc = tid & 15, nn = blockIdx.x * 16 + cc; float s = p.b_ada[nn];
            for (int k2 = 0; k2 < 32; ++k2) s += red[(k2 * 8 + b) * 16 + cc];
            mod[b * 3072 + nn] = s; }
        __syncthreads();
    }
    float* scr = (float*)(shm + wave * 8448);
    const int gw = blockIdx.x * 8 + wave, NGW = gridDim.x * 8;
    bf16_t* WinT = (bf16_t*)(p.ws + WS_WINT); bf16_t* WpgT = (bf16_t*)(p.ws + WS_WPGT);
    bf16_t* WpoT = (bf16_t*)(p.ws + WS_WPOT); bf16_t* WgoT = (bf16_t*)(p.ws + WS_WGOT); bf16_t* WoT = (bf16_t*)(p.ws + WS_WOT);
    constexpr int I1 = 16 * 160, I2 = 16 * 64, I3 = 4 * 4 * 8, I4 = 16 * 32;
    for (int it = gw; it < I1 + I2 + I3 + 3 * I4; it += NGW) {
        int r = it;
        if (r < I1) { tr_item(p.w_in, INW, 1024, WinT, 0, scr, r / 160, r % 160, lane); continue; } r -= I1;
        if (r < I2) { tr_item(p.w_in + 5136, INW, 1024, WinT, 5120, scr, r / 64, r % 64, lane); continue; } r -= I2;
        if (r < I3) { const int g = r >> 5, q = r & 31; tr_item(p.w_pg + (size_t)g * 65536, 256, 256, WpgT, g * 256, scr, q >> 3, q & 7, lane); continue; } r -= I3;
        if (r < I4) { tr_item(p.w_po, 1024, 1024, WpoT, 0, scr, r >> 5, r & 31, lane); continue; } r -= I4;
        if (r < I4) { tr_item(p.w_go, 1024, 1024, WgoT, 0, scr, r >> 5, r & 31, lane); continue; } r -= I4;
        tr_item(p.w_out, 1024, 1024, WoT, 0, scr, r >> 5, r & 31, lane);
    }
}

__device__ __forceinline__ void phase1(const Params& p, unsigned char* shm, int vid) {
    const int tid = fresh_tid(), lane = tid & 63, wave = __builtin_amdgcn_readfirstlane(tid >> 6);
    float* WA = (float*)shm;
    for (int i = tid; i < 16384; i += 512) { const int k = i >> 4, r = i & 15; WA[(((k & 3) << 8) + (k >> 2)) * 16 + r] = p.w_in[(size_t)k * INW + 5120 + r]; }
    __syncthreads();
    const float* mod = (const float*)(p.ws + WS_MOD);
    bf16_t* H = (bf16_t*)((unsigned char*)p.out + DO_H); float* ALOW = (float*)(p.ws + WS_ALOW);
    for (int kr = 0; kr < 16; ++kr) {
        const int row = (vid & 7) * SEQ + (vid >> 3) * 8 + wave + 256 * kr;
        const int b = row >> 12;
        const f32x4* xr = (const f32x4*)(p.x + (size_t)row * DM) + lane;
        f32x4 v[4]; float s = 0.f;
#pragma unroll
        for (int j = 0; j < 4; ++j) { v[j] = xr[64 * j]; s += (v[j][0] * v[j][0] + v[j][1] * v[j][1]) + (v[j][2] * v[j][2] + v[j][3] * v[j][3]); }
        const float rstd = 1.0f / sqrtf(wave_sum(s) * (1.f / DM) + EPSV);
        float acc[16];
#pragma unroll
        for (int r = 0; r < 16; ++r) acc[r] = 0.f;
#pragma unroll
        for (int j = 0; j < 4; ++j) { const int k = 4 * lane + 256 * j;
            const f32x4 g4 = *(const f32x4*)(p.g_norm + k), sh = *(const f32x4*)(mod + b * 3072 + k), sc = *(const f32x4*)(mod + b * 3072 + 1024 + k);
            const f32x4 h = v[j] * rstd * g4 * (sc + 1.0f) + sh;
            u32x2 w; w.x = cvt_pk_bf16(h[0], h[1]); w.y = cvt_pk_bf16(h[2], h[3]);
            *(u32x2*)(H + (size_t)row * DM + k) = w;
#pragma unroll
            for (int e = 0; e < 4; ++e) { const f32x4* wp = (const f32x4*)(WA + (e * 256 + lane + 64 * j) * 16);
#pragma unroll
                for (int q = 0; q < 4; ++q) { const f32x4 wv = wp[q];
                    acc[4 * q + 0] += h[e] * wv[0]; acc[4 * q + 1] += h[e] * wv[1]; acc[4 * q + 2] += h[e] * wv[2]; acc[4 * q + 3] += h[e] * wv[3]; }
                asm volatile("" ::: "memory"); } }
        float outv = 0.f;
#pragma unroll
        for (int r = 0; r < 16; ++r) { const float t = wave_sum(acc[r]); if (lane == r) outv = t; }
        if (lane < 16) ALOW[(size_t)row * 16 + lane] = outv;
    }
}

constexpr int QP = 136;
__device__ __forceinline__ void phase3(const Params& p, unsigned char* shm, int vid) {
    const int tid = fresh_tid(), lane = tid & 63, wave = __builtin_amdgcn_readfirstlane(tid >> 6);
    bf16_t* qd_s = (bf16_t*)shm; bf16_t* ki_s = (bf16_t*)(shm + 64 * QP * 2);
    float* al_s = (float*)(shm + 2 * 64 * QP * 2); float* gsum = al_s + 1024;
    const bf16_t* Z = (const bf16_t*)(p.ws + WS_Z); const float* ALOW = (const float*)(p.ws + WS_ALOW);
    bf16_t* QD = (bf16_t*)((unsigned char*)p.out + DO_QD); bf16_t* KET = (bf16_t*)((unsigned char*)p.out + DO_KET);
    bf16_t* PG = (bf16_t*)(p.ws + WS_PG); float* DEC = (float*)(p.ws + WS_DEC);
    const int d = tid & 127, tg = tid >> 7;
    for (int ku = 0; ku < 8; ++ku) {
        const int u = (vid & 7) * 256 + (vid >> 3) + 32 * ku;
        const int bh = u >> 6, n = u & 63, b = bh >> 2, h = bh & 3; const int row0 = b * SEQ + n * 64;
        if (tid < 256) *(f32x4*)(al_s + tid * 4) = *(const f32x4*)(ALOW + (size_t)row0 * 16 + tid * 4);
        float wup[16];
#pragma unroll
        for (int r = 0; r < 16; ++r) wup[r] = p.w_up[r * 512 + h * 128 + d];
        const float ba = p.b_alpha[h * 128 + d];
        __syncthreads();
        float bl[16]; float run = 0.f;
#pragma unroll
        for (int i = 0; i < 16; ++i) { const float* al = al_s + (tg * 16 + i) * 16; float xg = ba;
#pragma unroll
            for (int r = 0; r < 16; ++r) xg += al[r] * wup[r];
            const float ls = fminf(xg, 0.f) - __logf(1.0f + __expf(-fabsf(xg)));
            run += ls * 0.0625f; bl[i] = run; }
        gsum[tg * 128 + d] = run;
        __syncthreads();
        float prefix = 0.f, total = 0.f;
#pragma unroll
        for (int g2 = 0; g2 < 4; ++g2) { const float gs = gsum[g2 * 128 + d]; total += gs; if (g2 < tg) prefix += gs; }
        float kev[16];
#pragma unroll
        for (int i = 0; i < 16; ++i) { const int t = tg * 16 + i; const float bb = bl[i] + prefix;
            const float q = bf1(Z[(size_t)(row0 + t) * ZLD + ZC_Q + h * 128 + d]), k = bf1(Z[(size_t)(row0 + t) * ZLD + ZC_K + h * 128 + d]);
            const float qdv = q * 0.08838834764831845f * __expf(bb), kiv = k * __expf(-bb); kev[i] = k * __expf(total - bb);
            const unsigned pk = cvt_pk_bf16(qdv, kiv);
            qd_s[t * QP + d] = (bf16_t)(pk & 0xffffu); ki_s[t * QP + d] = (bf16_t)(pk >> 16);
            QD[(size_t)(row0 + t) * 512 + h * 128 + d] = (bf16_t)(pk & 0xffffu); }
        { u32x4 w0, w1;
          w0.x = cvt_pk_bf16(kev[0], kev[1]); w0.y = cvt_pk_bf16(kev[2], kev[3]); w0.z = cvt_pk_bf16(kev[4], kev[5]); w0.w = cvt_pk_bf16(kev[6], kev[7]);
          w1.x = cvt_pk_bf16(kev[8], kev[9]); w1.y = cvt_pk_bf16(kev[10], kev[11]); w1.z = cvt_pk_bf16(kev[12], kev[13]); w1.w = cvt_pk_bf16(kev[14], kev[15]);
          bf16_t* kp = KET + ((size_t)u * 128 + d) * 64 + tg * 16; *(u32x4*)kp = w0; *(u32x4*)(kp + 8) = w1; }
        if (tg == 0) DEC[u * 128 + d] = __expf(total);
        __syncthreads();
        const int it = wave >> 1, fr = lane & 15, fq = lane >> 4;
#pragma unroll
        for (int j2 = 0; j2 < 2; ++j2) { const int jt = (wave & 1) * 2 + j2; f32x4 acc = (f32x4){0.f, 0.f, 0.f, 0.f};
            if (jt <= it) {
#pragma unroll
                for (int kk = 0; kk < 4; ++kk) { const bf16x8 aq = *(const bf16x8*)(qd_s + (it * 16 + fr) * QP + kk * 32 + fq * 8), bk = *(const bf16x8*)(ki_s + (jt * 16 + fr) * QP + kk * 32 + fq * 8);
                    acc = __builtin_amdgcn_mfma_f32_16x16x32_bf16(bk, aq, acc, 0, 0, 0); } }
            const int i = it * 16 + fr, j0 = jt * 16 + fq * 4;
#pragma unroll
            for (int e = 0; e < 4; ++e) if (j0 + e > i) acc[e] = 0.f;
            u32x2 w; w.x = cvt_pk_bf16(acc[0], acc[1]); w.y = cvt_pk_bf16(acc[2], acc[3]);
            *(u32x2*)(PG + (size_t)u * 4096 + i * 64 + j0) = w; }
        __syncthreads();
    }
}

constexpr int VP = 72, SP = 136;
__device__ __forceinline__ void phase4(const Params& p, unsigned char* shm, int vid) {
    const int tid = fresh_tid(), lane = tid & 63, wave = __builtin_amdgcn_readfirstlane(tid >> 6);
    bf16_t* vT = (bf16_t*)shm;
    bf16_t* ST = (bf16_t*)(shm + 2 * 32 * VP * 2);
    bf16_t* Z = (bf16_t*)(p.ws + WS_Z);
    const bf16_t* QD = (const bf16_t*)((unsigned char*)p.out + DO_QD); const bf16_t* KET = (const bf16_t*)((unsigned char*)p.out + DO_KET);
    const bf16_t* PG = (const bf16_t*)(p.ws + WS_PG); const float* DEC = (const float*)(p.ws + WS_DEC);
    bf16_t* O = (bf16_t*)((unsigned char*)p.out + DO_O);
    const int fr = lane & 15, fq = lane >> 4, it = wave >> 1, ct = wave & 1, dt = wave;
    {
        const int b = vid & 7, h = vid >> 6, s = (vid >> 3) & 7, bh = b * 4 + h;
        for (int i = tid; i < 32 * SP; i += 512) ST[i] = 0;
        f32x4 sacc[2]; sacc[0] = (f32x4){0.f, 0.f, 0.f, 0.f}; sacc[1] = sacc[0];
        const int vj = tid >> 3, vc = (tid & 7) * 4;
        for (int n = 0; n < 64; ++n) {
            const int u = bh * 64 + n, row0 = b * SEQ + n * 64, buf = n & 1;
            bf16x8 Pf[2], Qf[4], Kf[2];
#pragma unroll
            for (int kk = 0; kk < 2; ++kk) Pf[kk] = *(const bf16x8*)(PG + (size_t)u * 4096 + (it * 16 + fr) * 64 + kk * 32 + fq * 8);
#pragma unroll
            for (int kk = 0; kk < 4; ++kk) Qf[kk] = *(const bf16x8*)(QD + (size_t)(row0 + it * 16 + fr) * 512 + h * 128 + kk * 32 + fq * 8);
#pragma unroll
            for (int kk = 0; kk < 2; ++kk) Kf[kk] = *(const bf16x8*)(KET + ((size_t)u * 128 + dt * 16 + fr) * 64 + kk * 32 + fq * 8);
            const f32x4 decv = *(const f32x4*)(DEC + u * 128 + dt * 16 + fq * 4);
            const u32x2 vv = *(const u32x2*)(Z + (size_t)(row0 + vj) * ZLD + ZC_V + h * 256 + s * 32 + vc);
            bf16_t* vb = vT + buf * 32 * VP;
            vb[(vc + 0) * VP + vj] = (bf16_t)(vv.x & 0xffffu); vb[(vc + 1) * VP + vj] = (bf16_t)(vv.x >> 16);
            vb[(vc + 2) * VP + vj] = (bf16_t)(vv.y & 0xffffu); vb[(vc + 3) * VP + vj] = (bf16_t)(vv.y >> 16);
            __syncthreads();
            bf16x8 Vf[2][2], Vo[2], Sf[4];
#pragma unroll
            for (int c2 = 0; c2 < 2; ++c2)
#pragma unroll
                for (int kk = 0; kk < 2; ++kk) Vf[c2][kk] = *(const bf16x8*)(vb + (c2 * 16 + fr) * VP + kk * 32 + fq * 8);
#pragma unroll
            for (int kk = 0; kk < 2; ++kk) Vo[kk] = *(const bf16x8*)(vb + (ct * 16 + fr) * VP + kk * 32 + fq * 8);
            const bf16_t* sb = ST + buf * 32 * SP;
#pragma unroll
            for (int kk = 0; kk < 4; ++kk) Sf[kk] = *(const bf16x8*)(sb + (ct * 16 + fr) * SP + kk * 32 + fq * 8);
            f32x4 oacc = (f32x4){0.f, 0.f, 0.f, 0.f};
#pragma unroll
            for (int kk = 0; kk < 2; ++kk) oacc = __builtin_amdgcn_mfma_f32_16x16x32_bf16(Vo[kk], Pf[kk], oacc, 0, 0, 0);
#pragma unroll
            for (int kk = 0; kk < 4; ++kk) oacc = __builtin_amdgcn_mfma_f32_16x16x32_bf16(Sf[kk], Qf[kk], oacc, 0, 0, 0);
            { u32x2 w; w.x = cvt_pk_bf16(oacc[0], oacc[1]); w.y = cvt_pk_bf16(oacc[2], oacc[3]);
              *(u32x2*)(O + (size_t)(row0 + it * 16 + fr) * 1024 + h * 256 + s * 32 + ct * 16 + fq * 4) = w; }
            bf16_t* sn = ST + (buf ^ 1) * 32 * SP;
#pragma unroll
            for (int c2 = 0; c2 < 2; ++c2) { sacc[c2] = sacc[c2] * decv;
#pragma unroll
                for (int kk = 0; kk < 2; ++kk) sacc[c2] = __builtin_amdgcn_mfma_f32_16x16x32_bf16(Kf[kk], Vf[c2][kk], sacc[c2], 0, 0, 0);
                u32x2 w; w.x = cvt_pk_bf16(sacc[c2][0], sacc[c2][1]); w.y = cvt_pk_bf16(sacc[c2][2], sacc[c2][3]);
                *(u32x2*)(sn + (c2 * 16 + fr) * SP + dt * 16 + fq * 4) = w; }
        }
        __syncthreads();
    }
    {
        const int item = (vid >> 3) * 512 + tid;
        const int cv = item & 127, b = vid & 7, t0 = (item >> 7) * 32, c = cv * 8, w = 2 << (cv >> 5);
        const bf16_t* src = Z + (size_t)b * SEQ * ZLD + ZC_PV + c; bf16_t* dst = Z + (size_t)b * SEQ * ZLD + ZC_POOLED + c;
        f32x4 s0 = (f32x4){0.f, 0.f, 0.f, 0.f}, s1 = s0;
        for (int j = 1; j <= w; ++j) { const int t = t0 - j; if (t >= 0) { f32x4 a0, a1; unpack8(*(const u32x4*)(src + (size_t)t * ZLD), a0, a1); s0 += a0; s1 += a1; } }
        for (int t = t0; t < t0 + 32; ++t) {
            f32x4 c0, c1; unpack8(*(const u32x4*)(src + (size_t)t * ZLD), c0, c1); s0 += c0; s1 += c1;
            if (t - w >= 0) { f32x4 a0, a1; unpack8(*(const u32x4*)(src + (size_t)(t - w) * ZLD), a0, a1); s0 -= a0; s1 -= a1; }
            const float inv = 1.0f / (float)((t + 1 < w) ? (t + 1) : w);
            *(u32x4*)(dst + (size_t)t * ZLD) = pack8(s0 * inv - c0, s1 * inv - c1);
        }
    }
}

__device__ __forceinline__ void phase5a(const Params& p, int vid) {
    const int tid = fresh_tid(), lane = tid & 63, wave = __builtin_amdgcn_readfirstlane(tid >> 6);
    bf16_t* Z = (bf16_t*)(p.ws + WS_Z); const bf16_t* O = (const bf16_t*)((unsigned char*)p.out + DO_O);
    for (int kr = 0; kr < 16; ++kr) {
        const int row = (vid & 7) * SEQ + (vid >> 3) * 8 + wave + 256 * kr;
#pragma unroll
        for (int j = 0; j < 2; ++j) { const int c = 8 * lane + 512 * j;
            f32x4 o0, o1; unpack8(*(const u32x4*)(O + (size_t)row * 1024 + c), o0, o1);
            float ss = (o0[0] * o0[0] + o0[1] * o0[1]) + (o0[2] * o0[2] + o0[3] * o0[3]) + (o1[0] * o1[0] + o1[1] * o1[1]) + (o1[2] * o1[2] + o1[3] * o1[3]);
#pragma unroll
            for (int of = 1; of < 32; of <<= 1) ss += __shfl_xor(ss, of);
            const float rstd = 1.0f / sqrtf(ss * (1.f / 256.f) + EPSV);
            const f32x4 g0 = *(const f32x4*)(p.g_gla + (c & 255)), g1 = *(const f32x4*)(p.g_gla + (c & 255) + 4);
            bf16_t* zp = Z + (size_t)row * ZLD + ZC_SGG + c;
            f32x4 s0, s1; unpack8(*(const u32x4*)zp, s0, s1);
            *(u32x4*)zp = pack8(o0 * rstd * g0 * s0, o1 * rstd * g1 * s1); }
    }
}
__device__ __forceinline__ void phase8(const Params& p, int vid) {
    const int tid = fresh_tid(), lane = tid & 63, wave = __builtin_amdgcn_readfirstlane(tid >> 6);
    for (int kr = 0; kr < 16; ++kr) {
        const int row = (vid & 7) * SEQ + (vid >> 3) * 8 + wave + 256 * kr;
        f32x4* yr = (f32x4*)(p.out + (size_t)row * DM) + lane;
        f32x4 v[4]; float s = 0.f;
#pragma unroll
        for (int j = 0; j < 4; ++j) { v[j] = yr[64 * j]; s += (v[j][0] * v[j][0] + v[j][1] * v[j][1]) + (v[j][2] * v[j][2] + v[j][3] * v[j][3]); }
        const float rstd = 1.0f / sqrtf(wave_sum(s) * (1.f / DM) + EPSV);
#pragma unroll
        for (int j = 0; j < 4; ++j) yr[64 * j] = v[j] * rstd * *(const f32x4*)(p.g_final + 4 * lane + 256 * j);
    }
}

#define GRID_SEAM() do { __builtin_amdgcn_fence(__ATOMIC_RELEASE, "agent"); asm volatile("s_waitcnt vmcnt(0) lgkmcnt(0)" ::: "memory"); __syncthreads(); \
    bar_epoch += 1u; \
    if (threadIdx.x == 0) { __hip_atomic_fetch_add(bar_ctr, 1u, __ATOMIC_RELEASE, __HIP_MEMORY_SCOPE_AGENT); \
        const unsigned target_ = bar_epoch * gridDim.x; \
        while (__hip_atomic_load(bar_ctr, __ATOMIC_RELAXED, __HIP_MEMORY_SCOPE_AGENT) < target_) __builtin_amdgcn_s_sleep(2); \
        __builtin_amdgcn_fence(__ATOMIC_ACQUIRE, "agent"); } \
    __syncthreads(); __builtin_amdgcn_fence(__ATOMIC_ACQUIRE, "agent"); asm volatile("s_waitcnt vmcnt(0)" ::: "memory"); } while (0)
#define XCD_SEAM() do { asm volatile("s_waitcnt vmcnt(0) lgkmcnt(0)" ::: "memory"); __syncthreads(); \
    x_epoch += 1u; \
    if (threadIdx.x == 0) { __hip_atomic_fetch_add(x_ctr, 1u, __ATOMIC_RELAXED, __HIP_MEMORY_SCOPE_AGENT); \
        const unsigned target_ = x_epoch * 32u; \
        while (__hip_atomic_load(x_ctr, __ATOMIC_RELAXED, __HIP_MEMORY_SCOPE_AGENT) < target_) __builtin_amdgcn_s_sleep(1); \
        __builtin_amdgcn_fence(__ATOMIC_ACQUIRE, "agent"); asm volatile("s_waitcnt vmcnt(0)" ::: "memory"); } \
    __syncthreads(); } while (0)
#define SEAM() do { if (affine) XCD_SEAM(); else GRID_SEAM(); } while (0)
__global__ void __launch_bounds__(512, 2) hybrid_fwd(Params p) {
    extern __shared__ __attribute__((aligned(16))) unsigned char shm[];
    cg::grid_group grid = cg::this_grid();
    const int tid0 = threadIdx.x;
    LAS unsigned char* lds = (LAS unsigned char*)shm;
    bf16_t* Z = (bf16_t*)(p.ws + WS_Z);
    const int G = gridDim.x;
    unsigned* bar_ctr = (unsigned*)(p.ws + WS_BAR); unsigned bar_epoch = 0u;
    unsigned* census = bar_ctr + 16;
    if (tid0 == 0) { const unsigned xcc = (unsigned)__builtin_amdgcn_s_getreg((3 << 11) | 20) & 0xFu;
        const unsigned ord = __hip_atomic_fetch_add(census + (xcc & 7u), 1u, __ATOMIC_RELAXED, __HIP_MEMORY_SCOPE_AGENT);
        ((unsigned*)shm)[0] = xcc & 7u; ((unsigned*)shm)[1] = ord; }
    __syncthreads();
    const unsigned my_xcc = (unsigned)__builtin_amdgcn_readfirstlane((int)((unsigned*)shm)[0]), my_ord = (unsigned)__builtin_amdgcn_readfirstlane((int)((unsigned*)shm)[1]);
    __syncthreads();
    grid.sync();

    phase0(p, shm);
    GRID_SEAM();
    bool affine; int vid;
    {
        unsigned cnt[8];
#pragma unroll
        for (int x = 0; x < 8; ++x) cnt[x] = __hip_atomic_load(census + x, __ATOMIC_RELAXED, __HIP_MEMORY_SCOPE_AGENT);
        if (my_ord < 32u) vid = (int)(my_ord * 8u + my_xcc);
        else { unsigned k = my_ord - 32u;
#pragma unroll
            for (int x = 0; x < 8; ++x) if ((unsigned)x < my_xcc && cnt[x] > 32u) k += cnt[x] - 32u;
            vid = -1;
#pragma unroll
            for (int x = 0; x < 8; ++x) { const unsigned holes = cnt[x] < 32u ? 32u - cnt[x] : 0u;
                if (vid < 0) { if (k < holes) vid = (int)((cnt[x] + k) * 8u + (unsigned)x); else k -= holes; } }
            if (vid < 0) vid = (int)blockIdx.x; }
        vid = __builtin_amdgcn_readfirstlane(vid);
        bool a = (G == 256);
#pragma unroll
        for (int x = 0; x < 8; ++x) a = a && (cnt[x] == 32u);
        affine = a;
    }
    unsigned* x_ctr = bar_ctr + 64 * (1 + (vid & 7)); unsigned x_epoch = 0u;
    const int cid = vid;
    phase1(p, shm, vid);
    SEAM();
    {
        pg8::Gemm g{(const bf16_t*)((unsigned char*)p.out + DO_H), (const bf16_t*)(p.ws + WS_WINT), 1024, 1024, 1024, 0};
        pg8::StaticOrder S; S.init(MTOK, ZLD, G, cid); EpiZ E{Z};
        pg8::gemm_phase<EpiZ>(lds, g, S, E);
#ifdef DBL_G1
        pg8::gemm_phase<EpiZ>(lds, g, S, E);
#endif
    }
    SEAM();
    phase3(p, shm, vid);
#ifdef DBL_P3
    __syncthreads(); phase3(p, shm, vid);
#endif
    SEAM();
    phase4(p, shm, vid);
#ifdef DBL_P4
    __syncthreads(); phase4(p, shm, vid);
#endif
    SEAM();
    phase5a(p, vid);
    {
        pg8::Gemm g{Z + ZC_POOLED, (const bf16_t*)(p.ws + WS_WPGT), ZLD, 256, 256, 512};
        pg8::StaticOrder S; S.init(MTOK, 1024, G, cid); EpiPool E{Z, p.pool_scale};
        pg8::gemm_phase<EpiPool>(lds, g, S, E);
    }
    SEAM();
    {
        pg8::Gemm g3{Z + ZC_YPOOL, (const bf16_t*)(p.ws + WS_WPOT), ZLD, 1024, 1024, 0};
        pg8::StaticOrder S; S.init(MTOK, 1024, G, cid); EpiT E3{Z};
        pg8::gemm_phase<EpiT>(lds, g3, S, E3);
        pg8::Gemm g4{Z + ZC_YGLA, (const bf16_t*)(p.ws + WS_WGOT), ZLD, 1024, 1024, 0};
        EpiMerge E4{Z};
        pg8::gemm_phase<EpiMerge>(lds, g4, S, E4);
    }
    SEAM();
    {
        pg8::Gemm g{Z + ZC_MERGED, (const bf16_t*)(p.ws + WS_WOT), ZLD, 1024, 1024, 0};
        pg8::StaticOrder S; S.init(MTOK, 1024, G, cid); EpiOut E{p.x, (const float*)(p.ws + WS_MOD), p.out};
        pg8::gemm_phase<EpiOut>(lds, g, S, E);
    }
    SEAM();
    phase8(p, vid);
}

extern "C" void kernel_launch(void* const* d_in, const int* in_sizes, int n_in, void* d_out, int out_size, void* d_ws, size_t ws_size, hipStream_t stream) {
    static int grid_blocks = 0;
    if (grid_blocks == 0) {
        if (ws_size < WS_END) { fprintf(stderr, "kernel_launch: workspace too small (%zu < %zu)\n", ws_size, (size_t)WS_END); grid_blocks = -1; return; }
        int dev = 0, cus = 0, per_cu = 0;
        hipGetDevice(&dev);
        hipDeviceGetAttribute(&cus, hipDeviceAttributeMultiprocessorCount, dev);
        if (hipFuncSetAttribute((const void*)hybrid_fwd, hipFuncAttributeMaxDynamicSharedMemorySize, LDS_BYTES) != hipSuccess) { fprintf(stderr, "kernel_launch: hipFuncSetAttribute failed\n"); grid_blocks = -1; return; }
        hipOccupancyMaxActiveBlocksPerMultiprocessor(&per_cu, (const void*)hybrid_fwd, 512, LDS_BYTES);
        if (per_cu < 1) per_cu = 1;
        grid_blocks = cus * per_cu;
        if (grid_blocks != 256) { fprintf(stderr, "kernel_launch: built for a 256-workgroup resident grid, got %d\n", grid_blocks); if (grid_blocks > 256) grid_blocks = 256; }
        (void)hipGetLastError();
    }
    if (grid_blocks < 0) return;
    Params p{};
    p.x = (const float*)d_in[0]; p.c = (const float*)d_in[1]; p.g_norm = (const float*)d_in[2]; p.w_ada = (const float*)d_in[3]; p.b_ada = (const float*)d_in[4];
    p.w_in = (const float*)d_in[5]; p.w_pg = (const float*)d_in[6]; p.pool_scale = (const float*)d_in[7]; p.w_up = (const float*)d_in[8]; p.b_alpha = (const float*)d_in[9];
    p.g_gla = (const float*)d_in[10]; p.w_po = (const float*)d_in[11]; p.w_go = (const float*)d_in[12]; p.w_out = (const float*)d_in[13]; p.g_final = (const float*)d_in[14];
    p.out = (float*)d_out; p.ws = (unsigned char*)d_ws;
    (void)hipMemsetAsync((unsigned char*)d_ws + WS_BAR, 0, 4096, stream);
    void* args[] = {&p};
    hipError_t e = hipLaunchCooperativeKernel((const void*)hybrid_fwd, dim3(grid_blocks), dim3(512), args, LDS_BYTES, stream);
    if (e != hipSuccess) fprintf(stderr, "cooperative launch failed: %s (grid %d)\n", hipGetErrorString(e), grid_blocks);
}
```

```cpp
#include <hip/hip_runtime.h>
#include <hip/hip_cooperative_groups.h>
#include <cstdio>
namespace cg = cooperative_groups;

#define LAS __attribute__((address_space(3)))
typedef unsigned short bf16_t;
typedef short bf16x8 __attribute__((ext_vector_type(8)));
typedef float f32x4 __attribute__((ext_vector_type(4)));
typedef unsigned u32x4 __attribute__((ext_vector_type(4)));
typedef unsigned u32x2 __attribute__((ext_vector_type(2)));

constexpr int DM = 1024, NB = 8, SEQ = 4096, MTOK = NB * SEQ;
constexpr int INW = 7184, ZN = 7168, ZLD = 7168;
constexpr int ZC_PV = 0, ZC_SPG = 1024, ZC_Q = 2048, ZC_K = 2560, ZC_V = 3072, ZC_SGG = 4096, ZC_SMP = 5120, ZC_SMG = 6144;
constexpr int ZC_YPOOL = 0, ZC_MERGED = 1024, ZC_POOLED = 2048, ZC_T = 2048, ZC_YGLA = 4096;
constexpr float EPSV = 1e-6f;
constexpr size_t WS_Z = 0;
constexpr size_t WS_WINT = WS_Z + (size_t)MTOK * ZLD * 2;
constexpr size_t WS_WPGT = WS_WINT + (size_t)ZN * 1024 * 2;
constexpr size_t WS_WPOT = WS_WPGT + (size_t)1024 * 256 * 2;
constexpr size_t WS_WGOT = WS_WPOT + (size_t)1024 * 1024 * 2;
constexpr size_t WS_WOT = WS_WGOT + (size_t)1024 * 1024 * 2;
constexpr size_t WS_MOD = WS_WOT + (size_t)1024 * 1024 * 2;
constexpr size_t WS_ALOW = WS_MOD + (size_t)8 * 3072 * 4;
constexpr size_t WS_PG = WS_ALOW + (size_t)MTOK * 16 * 4;
constexpr size_t WS_DEC = WS_PG + (size_t)2048 * 4096 * 2;
constexpr size_t WS_BAR = WS_DEC + (size_t)2048 * 128 * 4;
constexpr size_t WS_END = WS_BAR + 4096;
constexpr size_t DO_H = 0;
constexpr size_t DO_QD = 0;
constexpr size_t DO_KET = (size_t)MTOK * 512 * 2;
constexpr size_t DO_O = (size_t)MTOK * 1024 * 2;
constexpr int LDS_BYTES = 131072;

struct Params {
    const float *x, *c, *g_norm, *w_ada, *b_ada, *w_in, *w_pg, *pool_scale, *w_up, *b_alpha, *g_gla, *w_po, *w_go, *w_out, *g_final;
    float* out; unsigned char* ws;
};

typedef __bf16 bf16x2_t __attribute__((ext_vector_type(2)));
typedef float f32x2_t __attribute__((ext_vector_type(2)));
__device__ __forceinline__ unsigned cvt_pk_bf16(float lo, float hi) { const f32x2_t f = {lo, hi}; const bf16x2_t b = __builtin_convertvector(f, bf16x2_t); return __builtin_bit_cast(unsigned, b); }
__device__ __forceinline__ float bf_lo(unsigned u) { return __uint_as_float(u << 16); }
__device__ __forceinline__ float bf_hi(unsigned u) { return __uint_as_float(u & 0xffff0000u); }
__device__ __forceinline__ float bf1(bf16_t b) { return __uint_as_float(((unsigned)b) << 16); }
__device__ __forceinline__ float wave_sum(float v) {
#pragma unroll
    for (int o = 1; o < 64; o <<= 1) v += __shfl_xor(v, o);
    return v;
}
__device__ __forceinline__ float sigmoid_f(float x) { return __builtin_amdgcn_rcpf(1.0f + __expf(-x)); }
__device__ __forceinline__ float silu_f(float x) { return x * sigmoid_f(x); }
#define LDS_WAIT() asm volatile("s_waitcnt lgkmcnt(0)" ::: "memory")
__device__ __forceinline__ int fresh_tid() { int t = threadIdx.x; asm volatile("" : "+v"(t)); return t; }

namespace pg8 {
constexpr int BM = 256, BK = 64, HALF = 128, HTB = HALF * BK * 2, STAGE_BYTES = 8 * HTB, NXCD = 8, WGM = 8;
__device__ __forceinline__ int lds_byte(int r, int c) { const int st = (r >> 4) * 2 + (c >> 5), rr = r & 15, cc = c & 31, ob = rr * 64 + cc * 2; return st * 1024 + (ob ^ (((ob >> 9) & 1) << 5)); }
__device__ __forceinline__ void stage_rc(int b, int& R, int& C) { const int st = b / 1024, sb = b % 1024, swz = sb ^ (((sb >> 9) & 1) << 5); R = (st >> 1) * 16 + swz / 64; C = (st & 1) * 32 + (swz % 64) / 2; }
__device__ __forceinline__ int perm32(int rho) { const int n = rho >> 4, i = rho & 15; return 8 * (i >> 2) + 4 * n + (i & 3); }
struct Unit { int pm, pn; };
struct Gemm { const bf16_t* A; const bf16_t* Bt; int lda, ldb, K, a_pn_off; };
struct StaticOrder {
    int nM, nN, nwg, G, c;
    __device__ void init(int M, int N, int G_, int c_) { nM = M / BM; nN = N / BM; nwg = nM * nN; G = G_; c = c_; }
    __device__ bool next(int i, Unit& u) const {
        const long L = (long)i * G + c; if (L >= nwg) return false;
        int wgid = (int)L; { const int q = nwg / NXCD, r = nwg % NXCD, xcd = wgid % NXCD, off = wgid / NXCD; wgid = (xcd < r ? xcd * (q + 1) : r * (q + 1) + (xcd - r) * q) + off; }
        const int nig = WGM * nN, gid = wgid / nig, fm = gid * WGM, gsz = (nM - fm) < WGM ? (nM - fm) : WGM;
        u.pm = fm + ((wgid % nig) % gsz); u.pn = (wgid % nig) / gsz; return true;
    }
};

template <class Epi>
__device__ __forceinline__ void gemm_phase(LAS unsigned char* lds, const Gemm g, const StaticOrder& S, const Epi& E) {
    const int tid = fresh_tid(), wid = __builtin_amdgcn_readfirstlane(tid >> 6), lane = tid & 63, wr = wid >> 2, wc = wid & 3, fr = lane & 15, fq = lane >> 4;
    int nt = g.K / BK; asm volatile("" : "+s"(nt));
    unsigned voffA[2], voffB[2];
#pragma unroll
    for (int i = 0; i < 2; ++i) { int R, C; stage_rc(tid * 16 + i * 8192, R, C); const int Rb = Epi::PERM ? ((R & ~31) + perm32(R & 31)) : R;
        voffA[i] = (unsigned)(R * g.lda + C) * 2u; voffB[i] = (unsigned)(Rb * g.ldb + C) * 2u; }
    const size_t kstep = (size_t)(BK * 2);
    const size_t hA = (size_t)HALF * g.lda * 2, hB = (size_t)HALF * g.ldb * 2;
    const size_t tA = 2 * hA, tB = 2 * hB;
    const unsigned ldsw = (unsigned)wid * 1024u;
    const int aoff = lds_byte(wr * 64 + fr, fq * 8), boff = lds_byte(wc * 32 + fr, fq * 8);
#define PG8_SA(b, h) (((b) * 2 + (h)) * HTB)
#define PG8_SB(b, h) ((4 + (b) * 2 + (h)) * HTB)
#define PG8_STAGE(bufoff, gbase, voff) do { _Pragma("unroll") for (int _i = 0; _i < 2; ++_i) \
        __builtin_amdgcn_global_load_lds((const unsigned*)((const char*)(gbase) + (voff)[_i]), (LAS unsigned*)(lds + (bufoff) + ldsw + _i * 8192), 16, 0, 0); } while (0)
#define PG8_LDA(dst, b, h) do { _Pragma("unroll") for (int m = 0; m < 4; ++m) _Pragma("unroll") for (int k = 0; k < 2; ++k) dst[m][k] = *(const LAS bf16x8*)(lds + PG8_SA(b, h) + aoff + m * 2048 + k * 1024); } while (0)
#define PG8_LDB(dst, b, h) do { _Pragma("unroll") for (int n = 0; n < 2; ++n) _Pragma("unroll") for (int k = 0; k < 2; ++k) dst[n][k] = *(const LAS bf16x8*)(lds + PG8_SB(b, h) + boff + n * 2048 + k * 1024); } while (0)
#define PG8_MMA(ai, bj, At, Bt) do { __builtin_amdgcn_s_setprio(1); _Pragma("unroll") for (int m = 0; m < 4; ++m) _Pragma("unroll") for (int n = 0; n < 2; ++n) _Pragma("unroll") for (int k = 0; k < 2; ++k) \
        acc[ai][bj][m][n] = __builtin_amdgcn_mfma_f32_16x16x32_bf16(Bt[n][k], At[m][k], acc[ai][bj][m][n], 0, 0, 0); __builtin_amdgcn_s_setprio(0); } while (0)
#define PG8_WAIT_V(n) asm volatile("s_waitcnt vmcnt(" #n ")" ::: "memory")
#define PG8_WAIT_L(n) asm volatile("s_waitcnt lgkmcnt(" #n ")" ::: "memory")
#define PG8_BAR __builtin_amdgcn_s_barrier()
#define PG8_SCHED __builtin_amdgcn_sched_barrier(0)
    Unit cur, nxt; int ui = 0;
    if (!S.next(0, cur)) return;
    f32x4 acc[2][2][4][2];
#pragma unroll
    for (int a = 0; a < 2; ++a)
#pragma unroll
        for (int b = 0; b < 2; ++b)
#pragma unroll
            for (int m = 0; m < 4; ++m)
#pragma unroll
                for (int n = 0; n < 2; ++n) acc[a][b][m][n] = (f32x4){0.f, 0.f, 0.f, 0.f};
    bf16x8 At[4][2], B0[2][2], B1[2][2];
    const char* cA = (const char*)g.A + (size_t)cur.pm * tA + (size_t)cur.pn * g.a_pn_off; const char* cB = (const char*)g.Bt + (size_t)cur.pn * tB;
    PG8_STAGE(PG8_SB(0, 0), cB, voffB); PG8_STAGE(PG8_SA(0, 0), cA, voffA); PG8_STAGE(PG8_SB(0, 1), cB + hB, voffB); PG8_STAGE(PG8_SA(0, 1), cA + hA, voffA);
    if (wr == 1) PG8_BAR;
    PG8_WAIT_V(4); PG8_BAR;
    PG8_STAGE(PG8_SB(1, 0), cB + kstep, voffB); PG8_STAGE(PG8_SA(1, 0), cA + kstep, voffA); PG8_STAGE(PG8_SB(1, 1), cB + hB + kstep, voffB);
    PG8_WAIT_V(6); PG8_BAR;
    for (;;) {
        const bool has_next = S.next(ui + 1, nxt);
        const char* nA = has_next ? (const char*)g.A + (size_t)nxt.pm * tA + (size_t)nxt.pn * g.a_pn_off : cA; const char* nB = has_next ? (const char*)g.Bt + (size_t)nxt.pn * tB : cB;
        for (int t = 0; t < nt; t += 2) {
            const bool last = (t == nt - 2);
            const char* a1 = cA + (size_t)(t + 1) * kstep;
            const char* a2 = last ? nA : cA + (size_t)(t + 2) * kstep; const char* b2 = last ? nB : cB + (size_t)(t + 2) * kstep;
            const char* a3 = a2 + kstep; const char* b3 = b2 + kstep;
            PG8_LDB(B0, 0, 0); PG8_SCHED; PG8_LDA(At, 0, 0); PG8_STAGE(PG8_SA(1, 1), a1 + hA, voffA);
            PG8_WAIT_L(8); PG8_BAR; PG8_WAIT_L(0); PG8_MMA(0, 0, At, B0); PG8_BAR; PG8_SCHED;
            PG8_LDB(B1, 0, 1); PG8_STAGE(PG8_SB(0, 0), b2, voffB);
            PG8_BAR; PG8_WAIT_L(0); PG8_MMA(0, 1, At, B1); PG8_BAR;
            PG8_LDA(At, 0, 1); PG8_STAGE(PG8_SA(0, 0), a2, voffA);
            PG8_BAR; PG8_WAIT_L(0); PG8_MMA(1, 0, At, B0); PG8_BAR; PG8_SCHED;
            PG8_STAGE(PG8_SB(0, 1), b2 + hB, voffB);
            PG8_WAIT_V(6); PG8_BAR; PG8_MMA(1, 1, At, B1); PG8_BAR;
            PG8_LDB(B0, 1, 0); PG8_SCHED; PG8_LDA(At, 1, 0); PG8_STAGE(PG8_SA(0, 1), a2 + hA, voffA);
            PG8_WAIT_L(8); PG8_BAR; PG8_WAIT_L(0); PG8_MMA(0, 0, At, B0); PG8_BAR; PG8_SCHED;
            PG8_LDB(B1, 1, 1); PG8_STAGE(PG8_SB(1, 0), b3, voffB);
            PG8_BAR; PG8_WAIT_L(0); PG8_MMA(0, 1, At, B1); PG8_BAR;
            PG8_LDA(At, 1, 1); PG8_STAGE(PG8_SA(1, 0), a3, voffA);
            PG8_BAR; PG8_WAIT_L(0); PG8_MMA(1, 0, At, B0); PG8_BAR; PG8_SCHED;
            PG8_STAGE(PG8_SB(1, 1), b3 + hB, voffB);
            PG8_WAIT_V(6); PG8_BAR; PG8_MMA(1, 1, At, B1); PG8_BAR;
        }
        E(acc, cur, wr, wc, fr, fq);
        if (!has_next) break;
#pragma unroll
        for (int a = 0; a < 2; ++a)
#pragma unroll
            for (int b = 0; b < 2; ++b)
#pragma unroll
                for (int m = 0; m < 4; ++m)
#pragma unroll
                    for (int n = 0; n < 2; ++n) acc[a][b][m][n] = (f32x4){0.f, 0.f, 0.f, 0.f};
        cur = nxt; cA = nA; cB = nB; ++ui;
    }
    PG8_WAIT_V(0);
    if (wr == 0) PG8_BAR;
    PG8_BAR;
#undef PG8_SA
#undef PG8_SB
#undef PG8_STAGE
#undef PG8_LDA
#undef PG8_LDB
#undef PG8_MMA
#undef PG8_WAIT_V
#undef PG8_WAIT_L
#undef PG8_BAR
#undef PG8_SCHED
}
}

typedef f32x4 AccT[2][2][4][2];
__device__ __forceinline__ u32x4 pack8(f32x4 v0, f32x4 v1) { u32x4 w; w.x = cvt_pk_bf16(v0[0], v0[1]); w.y = cvt_pk_bf16(v0[2], v0[3]); w.z = cvt_pk_bf16(v1[0], v1[1]); w.w = cvt_pk_bf16(v1[2], v1[3]); return w; }
__device__ __forceinline__ void unpack8(u32x4 w, f32x4& v0, f32x4& v1) { v0 = (f32x4){bf_lo(w.x), bf_hi(w.x), bf_lo(w.y), bf_hi(w.y)}; v1 = (f32x4){bf_lo(w.z), bf_hi(w.z), bf_lo(w.w), bf_hi(w.w)}; }

struct EpiZ {
    static constexpr bool PERM = true;
    bf16_t* Z;
    template <int ACT> __device__ __forceinline__ void run(const AccT& acc, const pg8::Unit& u, int, int, int, int) const {
        const int t_ = fresh_tid(), l_ = t_ & 63, w_ = __builtin_amdgcn_readfirstlane(t_ >> 6), wr = w_ >> 2, wc = w_ & 3, fr = l_ & 15, fq = l_ >> 4;
        const int row0 = u.pm * 256 + wr * 64 + fr, col0 = u.pn * 256 + wc * 32 + 8 * fq;
#pragma unroll
        for (int ai = 0; ai < 2; ++ai)
#pragma unroll
            for (int m = 0; m < 4; ++m) { bf16_t* rowp = Z + (size_t)(row0 + ai * 128 + m * 16) * ZLD + col0;
#pragma unroll
                for (int bj = 0; bj < 2; ++bj) { f32x4 v0 = acc[ai][bj][m][0], v1 = acc[ai][bj][m][1];
                    if (ACT == 1) {
#pragma unroll
                        for (int j = 0; j < 4; ++j) { v0[j] = silu_f(v0[j]); v1[j] = silu_f(v1[j]); } }
                    if (ACT == 2) {
#pragma unroll
                        for (int j = 0; j < 4; ++j) { v0[j] = sigmoid_f(v0[j]); v1[j] = sigmoid_f(v1[j]); } }
                    *(u32x4*)(rowp + bj * 128) = pack8(v0, v1); } }
    }
    __device__ __forceinline__ void operator()(const AccT& acc, const pg8::Unit& u, int wr, int wc, int fr, int fq) const {
        const int pn = u.pn;
        if ((pn >= 4 && pn < 8) || (pn >= 16 && pn < 20)) run<1>(acc, u, wr, wc, fr, fq);
        else if (pn >= 20) run<2>(acc, u, wr, wc, fr, fq);
        else run<0>(acc, u, wr, wc, fr, fq);
    }
};
struct EpiPool {
    static constexpr bool PERM = true;
    bf16_t* Z; const float* pool_scale;
    __device__ __forceinline__ void operator()(const AccT& acc, const pg8::Unit& u, int, int, int, int) const {
        const int t_ = fresh_tid(), l_ = t_ & 63, w_ = __builtin_amdgcn_readfirstlane(t_ >> 6), wr = w_ >> 2, wc = w_ & 3, fr = l_ & 15, fq = l_ >> 4;
        const int row0 = u.pm * 256 + wr * 64 + fr, col0 = u.pn * 256 + wc * 32 + 8 * fq;
#pragma unroll
        for (int bj = 0; bj < 2; ++bj) { const f32x4 s0 = *(const f32x4*)(pool_scale + col0 + bj * 128), s1 = *(const f32x4*)(pool_scale + col0 + bj * 128 + 4);
#pragma unroll
            for (int ai = 0; ai < 2; ++ai)
#pragma unroll
                for (int m = 0; m < 4; ++m) { bf16_t* rowp = Z + (size_t)(row0 + ai * 128 + m * 16) * ZLD + col0 + bj * 128;
                    f32x4 g0, g1; unpack8(*(const u32x4*)(rowp + ZC_SPG), g0, g1);
                    *(u32x4*)(rowp + ZC_YPOOL) = pack8(acc[ai][bj][m][0] * s0 * g0, acc[ai][bj][m][1] * s1 * g1);
                    if (m & 1) asm volatile("" ::: "memory"); } }
    }
};
struct EpiT {
    static constexpr bool PERM = true;
    bf16_t* Z;
    __device__ __forceinline__ void operator()(const AccT& acc, const pg8::Unit& u, int, int, int, int) const {
        const int t_ = fresh_tid(), l_ = t_ & 63, w_ = __builtin_amdgcn_readfirstlane(t_ >> 6), wr = w_ >> 2, wc = w_ & 3, fr = l_ & 15, fq = l_ >> 4;
        const int row0 = u.pm * 256 + wr * 64 + fr, col0 = u.pn * 256 + wc * 32 + 8 * fq;
#pragma unroll
        for (int ai = 0; ai < 2; ++ai)
#pragma unroll
            for (int m = 0; m < 4; ++m)
#pragma unroll
                for (int bj = 0; bj < 2; ++bj) { bf16_t* rowp = Z + (size_t)(row0 + ai * 128 + m * 16) * ZLD + col0 + bj * 128;
                    f32x4 g0, g1; unpack8(*(const u32x4*)(rowp + ZC_SMP), g0, g1);
                    *(u32x4*)(rowp + ZC_T) = pack8(acc[ai][bj][m][0] * g0, acc[ai][bj][m][1] * g1);
                    if (bj) asm volatile("" ::: "memory"); }
    }
};
struct EpiMerge {
    static constexpr bool PERM = true;
    bf16_t* Z;
    __device__ __forceinline__ void operator()(const AccT& acc, const pg8::Unit& u, int, int, int, int) const {
        const int t_ = fresh_tid(), l_ = t_ & 63, w_ = __builtin_amdgcn_readfirstlane(t_ >> 6), wr = w_ >> 2, wc = w_ & 3, fr = l_ & 15, fq = l_ >> 4;
        const int row0 = u.pm * 256 + wr * 64 + fr, col0 = u.pn * 256 + wc * 32 + 8 * fq;
#pragma unroll
        for (int ai = 0; ai < 2; ++ai)
#pragma unroll
            for (int m = 0; m < 4; ++m)
#pragma unroll
                for (int bj = 0; bj < 2; ++bj) { bf16_t* rowp = Z + (size_t)(row0 + ai * 128 + m * 16) * ZLD + col0 + bj * 128;
                    f32x4 g0, g1, t0, t1; unpack8(*(const u32x4*)(rowp + ZC_SMG), g0, g1); unpack8(*(const u32x4*)(rowp + ZC_T), t0, t1);
                    *(u32x4*)(rowp + ZC_MERGED) = pack8(t0 + acc[ai][bj][m][0] * g0, t1 + acc[ai][bj][m][1] * g1);
                    if (bj) asm volatile("" ::: "memory"); }
    }
};
struct EpiU {
    static constexpr bool PERM = true;
    bf16_t* Z;
    __device__ __forceinline__ void operator()(const AccT& acc, const pg8::Unit& u, int, int, int, int) const {
        const int t_ = fresh_tid(), l_ = t_ & 63, w_ = __builtin_amdgcn_readfirstlane(t_ >> 6), wr = w_ >> 2, wc = w_ & 3, fr = l_ & 15, fq = l_ >> 4;
        const int row0 = u.pm * 256 + wr * 64 + fr, col0 = u.pn * 256 + wc * 32 + 8 * fq;
#pragma unroll
        for (int ai = 0; ai < 2; ++ai)
#pragma unroll
            for (int m = 0; m < 4; ++m)
#pragma unroll
                for (int bj = 0; bj < 2; ++bj)
                    *(u32x4*)(Z + (size_t)(row0 + ai * 128 + m * 16) * ZLD + col0 + bj * 128 + ZC_T) = pack8(acc[ai][bj][m][0], acc[ai][bj][m][1]);
    }
};

__device__ __forceinline__ void tr_item(const float* W, int ldw, int K, bf16_t* WT, int row_off, float* scr, int kb, int nb, int lane) {
    const int k0 = 64 * kb, n0 = 32 * nb;
#pragma unroll 8
    for (int i = 0; i < 32; ++i) { const int kk = 2 * i + (lane >> 5); scr[kk * 33 + (lane & 31)] = W[(size_t)(k0 + kk) * ldw + n0 + (lane & 31)]; }
    LDS_WAIT();
    const int c = lane & 7;
#pragma unroll
    for (int j = 0; j < 4; ++j) { const int n = (lane >> 3) + 8 * j; const float* s = scr + (8 * c) * 33 + n;
        u32x4 o; o.x = cvt_pk_bf16(s[0 * 33], s[1 * 33]); o.y = cvt_pk_bf16(s[2 * 33], s[3 * 33]); o.z = cvt_pk_bf16(s[4 * 33], s[5 * 33]); o.w = cvt_pk_bf16(s[6 * 33], s[7 * 33]);
        *(u32x4*)(WT + (size_t)(row_off + n0 + n) * K + k0 + 8 * c) = o; }
    LDS_WAIT();
}
__device__ __forceinline__ void phase0(const Params& p, unsigned char* shm) {
    const int tid = fresh_tid(), lane = tid & 63, wave = __builtin_amdgcn_readfirstlane(tid >> 6);
    float* mod = (float*)(p.ws + WS_MOD);
    if (blockIdx.x < 192) {
        float* sc = (float*)shm; float* red = (float*)(shm + 32768);
        for (int i = tid; i < 8192; i += 512) sc[i] = silu_f(p.c[i]);
        __syncthreads();
        const int col = tid & 15, ks = tid >> 4, n = blockIdx.x * 16 + col;
        float a[8];
#pragma unroll
        for (int b = 0; b < 8; ++b) a[b] = 0.f;
#pragma unroll 4
        for (int kk = 0; kk < 32; ++kk) { const int k = ks * 32 + kk; const float w = p.w_ada[(size_t)k * 3072 + n];
#pragma unroll
            for (int b = 0; b < 8; ++b) a[b] += sc[b * 1024 + k] * w; }
#pragma unroll
        for (int b = 0; b < 8; ++b) red[(ks * 8 + b) * 16 + col] = a[b];
        __syncthreads();
        if (tid < 128) { const int b = tid >> 4, cc = tid & 15, nn = blockIdx.x * 16 + cc; float s = p.b_ada[nn];
            for (int k2 = 0; k2 < 32; ++k2) s += red[(k2 * 8 + b) * 16 + cc];
            mod[b * 3072 + nn] = s; }
        __syncthreads();
    }
    float* scr = (float*)(shm + wave * 8448);
    const int gw = blockIdx.x * 8 + wave, NGW = gridDim.x * 8;
    bf16_t* WinT = (bf16_t*)(p.ws + WS_WINT); bf16_t* WpgT = (bf16_t*)(p.ws + WS_WPGT);
    bf16_t* WpoT = (bf16_t*)(p.ws + WS_WPOT); bf16_t* WgoT = (bf16_t*)(p.ws + WS_WGOT); bf16_t* WoT = (bf16_t*)(p.ws + WS_WOT);
    constexpr int I1 = 16 * 160, I2 = 16 * 64, I3 = 4 * 4 * 8, I4 = 16 * 32;
    for (int it = gw; it < I1 + I2 + I3 + 3 * I4; it += NGW) {
        int r = it;
        if (r < I1) { tr_item(p.w_in, INW, 1024, WinT, 0, scr, r / 160, r % 160, lane); continue; } r -= I1;
        if (r < I2) { tr_item(p.w_in + 5136, INW, 1024, WinT, 5120, scr, r / 64, r % 64, lane); continue; } r -= I2;
        if (r < I3) { const int g = r >> 5, q = r & 31; tr_item(p.w_pg + (size_t)g * 65536, 256, 256, WpgT, g * 256, scr, q >> 3, q & 7, lane); continue; } r -= I3;
        if (r < I4) { tr_item(p.w_po, 1024, 1024, WpoT, 0, scr, r >> 5, r & 31, lane); continue; } r -= I4;
        if (r < I4) { tr_item(p.w_go, 1024, 1024, WgoT, 0, scr, r >> 5, r & 31, lane); continue; } r -= I4;
        tr_item(p.w_out, 1024, 1024, WoT, 0, scr, r >> 5, r & 31, lane);
    }
}

__device__ __forceinline__ void phase1(const Params& p, unsigned char* shm, int vid) {
    const int tid = fresh_tid(), lane = tid & 63, wave = __builtin_amdgcn_readfirstlane(tid >> 6);
    float* WA = (float*)shm;
    for (int i = tid; i < 16384; i += 512) { const int k = i >> 4, r = i & 15; WA[(((k & 3) << 8) + (k >> 2)) * 16 + r] = p.w_in[(size_t)k * INW + 5120 + r]; }
    __syncthreads();
    const float* mod = (const float*)(p.ws + WS_MOD);
    bf16_t* H = (bf16_t*)((unsigned char*)p.out + DO_H); float* ALOW = (float*)(p.ws + WS_ALOW);
    for (int kr = 0; kr < 16; ++kr) {
        const int row = (vid & 7) * SEQ + (vid >> 3) * 8 + wave + 256 * kr;
        const int b = row >> 12;
        const f32x4* xr = (const f32x4*)(p.x + (size_t)row * DM) + lane;
        f32x4 v[4]; float s = 0.f;
#pragma unroll
        for (int j = 0; j < 4; ++j) { v[j] = xr[64 * j]; s += (v[j][0] * v[j][0] + v[j][1] * v[j][1]) + (v[j][2] * v[j][2] + v[j][3] * v[j][3]); }
        const float rstd = 1.0f / sqrtf(wave_sum(s) * (1.f / DM) + EPSV);
        float acc[16];
#pragma unroll
        for (int r = 0; r < 16; ++r) acc[r] = 0.f;
#pragma unroll
        for (int j = 0; j < 4; ++j) { const int k = 4 * lane + 256 * j;
            const f32x4 g4 = *(const f32x4*)(p.g_norm + k), sh = *(const f32x4*)(mod + b * 3072 + k), sc = *(const f32x4*)(mod + b * 3072 + 1024 + k);
            const f32x4 h = v[j] * rstd * g4 * (sc + 1.0f) + sh;
            u32x2 w; w.x = cvt_pk_bf16(h[0], h[1]); w.y = cvt_pk_bf16(h[2], h[3]);
            *(u32x2*)(H + (size_t)row * DM + k) = w;
#pragma unroll
            for (int e = 0; e < 4; ++e) { const f32x4* wp = (const f32x4*)(WA + (e * 256 + lane + 64 * j) * 16);
#pragma unroll
                for (int q = 0; q < 4; ++q) { const f32x4 wv = wp[q];
                    acc[4 * q + 0] += h[e] * wv[0]; acc[4 * q + 1] += h[e] * wv[1]; acc[4 * q + 2] += h[e] * wv[2]; acc[4 * q + 3] += h[e] * wv[3]; }
                asm volatile("" ::: "memory"); } }
        float outv = 0.f;
#pragma unroll
        for (int r = 0; r < 16; ++r) { const float t = wave_sum(acc[r]); if (lane == r) outv = t; }
        if (lane < 16) ALOW[(size_t)row * 16 + lane] = outv;
    }
}

constexpr int QP = 136;
__device__ __forceinline__ void phase3(const Params& p, unsigned char* shm, int vid) {
    const int tid = fresh_tid(), lane = tid & 63, wave = __builtin_amdgcn_readfirstlane(tid >> 6);
    bf16_t* qd_s = (bf16_t*)shm; bf16_t* ki_s = (bf16_t*)(shm + 64 * QP * 2);
    float* al_s = (float*)(shm + 2 * 64 * QP * 2); float* gsum = al_s + 1024;
    const bf16_t* Z = (const bf16_t*)(p.ws + WS_Z); const float* ALOW = (const float*)(p.ws + WS_ALOW);
    bf16_t* QD = (bf16_t*)((unsigned char*)p.out + DO_QD); bf16_t* KET = (bf16_t*)((unsigned char*)p.out + DO_KET);
    bf16_t* PG = (bf16_t*)(p.ws + WS_PG); float* DEC = (float*)(p.ws + WS_DEC);
    const int d = tid & 127, tg = tid >> 7;
    for (int ku = 0; ku < 8; ++ku) {
        const int u = (vid & 7) * 256 + (vid >> 3) + 32 * ku;
        const int bh = u >> 6, n = u & 63, b = bh >> 2, h = bh & 3; const int row0 = b * SEQ + n * 64;
        if (tid < 256) *(f32x4*)(al_s + tid * 4) = *(const f32x4*)(ALOW + (size_t)row0 * 16 + tid * 4);
        float wup[16];
#pragma unroll
        for (int r = 0; r < 16; ++r) wup[r] = p.w_up[r * 512 + h * 128 + d];
        const float ba = p.b_alpha[h * 128 + d];
        __syncthreads();
        float bl[16]; float run = 0.f;
#pragma unroll
        for (int i = 0; i < 16; ++i) { const float* al = al_s + (tg * 16 + i) * 16; float xg = ba;
#pragma unroll
            for (int r = 0; r < 16; ++r) xg += al[r] * wup[r];
            const float ls = fminf(xg, 0.f) - __logf(1.0f + __expf(-fabsf(xg)));
            run += ls * 0.0625f; bl[i] = run; }
        gsum[tg * 128 + d] = run;
        __syncthreads();
        float prefix = 0.f, total = 0.f;
#pragma unroll
        for (int g2 = 0; g2 < 4; ++g2) { const float gs = gsum[g2 * 128 + d]; total += gs; if (g2 < tg) prefix += gs; }
        float kev[16];
#pragma unroll
        for (int i = 0; i < 16; ++i) { const int t = tg * 16 + i; const float bb = bl[i] + prefix;
            const float q = bf1(Z[(size_t)(row0 + t) * ZLD + ZC_Q + h * 128 + d]), k = bf1(Z[(size_t)(row0 + t) * ZLD + ZC_K + h * 128 + d]);
            const float qdv = q * 0.08838834764831845f * __expf(bb), kiv = k * __expf(-bb); kev[i] = k * __expf(total - bb);
            const unsigned pk = cvt_pk_bf16(qdv, kiv);
            qd_s[t * QP + d] = (bf16_t)(pk & 0xffffu); ki_s[t * QP + d] = (bf16_t)(pk >> 16); }
        { u32x4 w0, w1;
          w0.x = cvt_pk_bf16(kev[0], kev[1]); w0.y = cvt_pk_bf16(kev[2], kev[3]); w0.z = cvt_pk_bf16(kev[4], kev[5]); w0.w = cvt_pk_bf16(kev[6], kev[7]);
          w1.x = cvt_pk_bf16(kev[8], kev[9]); w1.y = cvt_pk_bf16(kev[10], kev[11]); w1.z = cvt_pk_bf16(kev[12], kev[13]); w1.w = cvt_pk_bf16(kev[14], kev[15]);
          bf16_t* kp = KET + ((((size_t)u * 8 + (d >> 4)) * 2 + (tg >> 1)) * 64 + (tg & 1) * 32 + (d & 15)) * 8; *(u32x4*)kp = w0; *(u32x4*)(kp + 128) = w1; }
        if (tg == 0) DEC[u * 128 + d] = __expf(total);
        __syncthreads();
        const int it = wave >> 1, fr = lane & 15, fq = lane >> 4;
        bf16x8 aq[4];
#pragma unroll
        for (int kk = 0; kk < 4; ++kk) aq[kk] = *(const bf16x8*)(qd_s + (it * 16 + fr) * QP + kk * 32 + fq * 8);
        if ((wave & 1) == 0) {
#pragma unroll
            for (int kk = 0; kk < 4; ++kk) *(bf16x8*)(QD + ((((size_t)u * 4 + it) * 4 + kk) * 64 + lane) * 8) = aq[kk]; }
#pragma unroll
        for (int j2 = 0; j2 < 2; ++j2) { const int jt = (wave & 1) * 2 + j2; f32x4 acc = (f32x4){0.f, 0.f, 0.f, 0.f};
            if (jt <= it) {
#pragma unroll
                for (int kk = 0; kk < 4; ++kk) { const bf16x8 bk = *(const bf16x8*)(ki_s + (jt * 16 + fr) * QP + kk * 32 + fq * 8);
                    acc = __builtin_amdgcn_mfma_f32_16x16x32_bf16(bk, aq[kk], acc, 0, 0, 0); } }
            const int i = it * 16 + fr, j0 = jt * 16 + fq * 4;
#pragma unroll
            for (int e = 0; e < 4; ++e) if (j0 + e > i) acc[e] = 0.f;
            u32x2 w; w.x = cvt_pk_bf16(acc[0], acc[1]); w.y = cvt_pk_bf16(acc[2], acc[3]);
            *(u32x2*)(PG + ((((size_t)u * 4 + it) * 2 + (jt >> 1)) * 64 + ((jt & 1) * 2 + (fq >> 1)) * 16 + fr) * 8 + (fq & 1) * 4) = w; }
        __syncthreads();
    }
}

constexpr int VP = 72, SP = 136;
struct ScanRegs { bf16x8 Pf[2], Qf[4], Kf[2]; f32x4 decv; u32x2 vv; };
__device__ __forceinline__ void scan_load(ScanRegs& r, const bf16_t* PG, const bf16_t* QD, const bf16_t* KET, const float* DEC, const bf16_t* Z,
                                          int u, int row0, int h, int s, int it, int dt, int fr, int fq, int vj, int vc) {
#pragma unroll
    for (int kk = 0; kk < 2; ++kk) r.Pf[kk] = *(const bf16x8*)(PG + ((((size_t)u * 4 + it) * 2 + kk) * 64 + fq * 16 + fr) * 8);
#pragma unroll
    for (int kk = 0; kk < 4; ++kk) r.Qf[kk] = *(const bf16x8*)(QD + ((((size_t)u * 4 + it) * 4 + kk) * 64 + fq * 16 + fr) * 8);
#pragma unroll
    for (int kk = 0; kk < 2; ++kk) r.Kf[kk] = *(const bf16x8*)(KET + ((((size_t)u * 8 + dt) * 2 + kk) * 64 + fq * 16 + fr) * 8);
    r.decv = *(const f32x4*)(DEC + u * 128 + dt * 16 + fq * 4);
    r.vv = *(const u32x2*)(Z + (size_t)(row0 + vj) * ZLD + ZC_V + h * 256 + s * 32 + vc);
}
__device__ __forceinline__ void scan_step(const ScanRegs& r, f32x4 (&sacc)[2], bf16_t* vT, bf16_t* ST, bf16_t* O, int buf, int row0, int h, int s,
                                          int it, int ct, int dt, int fr, int fq, int vj, int vc) {
    bf16_t* vb = vT + buf * 32 * VP;
    vb[(vc + 0) * VP + vj] = (bf16_t)(r.vv.x & 0xffffu); vb[(vc + 1) * VP + vj] = (bf16_t)(r.vv.x >> 16);
    vb[(vc + 2) * VP + vj] = (bf16_t)(r.vv.y & 0xffffu); vb[(vc + 3) * VP + vj] = (bf16_t)(r.vv.y >> 16);
    __syncthreads();
    bf16x8 Vf[2][2], Vo[2], Sf[4];
#pragma unroll
    for (int c2 = 0; c2 < 2; ++c2)
#pragma unroll
        for (int kk = 0; kk < 2; ++kk) Vf[c2][kk] = *(const bf16x8*)(vb + (c2 * 16 + fr) * VP + kk * 32 + fq * 8);
#pragma unroll
    for (int kk = 0; kk < 2; ++kk) Vo[kk] = *(const bf16x8*)(vb + (ct * 16 + fr) * VP + kk * 32 + fq * 8);
    const bf16_t* sb = ST + buf * 32 * SP;
#pragma unroll
    for (int kk = 0; kk < 4; ++kk) Sf[kk] = *(const bf16x8*)(sb + (ct * 16 + fr) * SP + kk * 32 + fq * 8);
    f32x4 oacc = (f32x4){0.f, 0.f, 0.f, 0.f};
#pragma unroll
    for (int kk = 0; kk < 2; ++kk) oacc = __builtin_amdgcn_mfma_f32_16x16x32_bf16(Vo[kk], r.Pf[kk], oacc, 0, 0, 0);
#pragma unroll
    for (int kk = 0; kk < 4; ++kk) oacc = __builtin_amdgcn_mfma_f32_16x16x32_bf16(Sf[kk], r.Qf[kk], oacc, 0, 0, 0);
    { u32x2 w; w.x = cvt_pk_bf16(oacc[0], oacc[1]); w.y = cvt_pk_bf16(oacc[2], oacc[3]);
      *(u32x2*)(O + (size_t)(row0 + it * 16 + fr) * 1024 + h * 256 + s * 32 + ct * 16 + fq * 4) = w; }
    bf16_t* sn = ST + (buf ^ 1) * 32 * SP;
#pragma unroll
    for (int c2 = 0; c2 < 2; ++c2) { sacc[c2] = sacc[c2] * r.decv;
#pragma unroll
        for (int kk = 0; kk < 2; ++kk) sacc[c2] = __builtin_amdgcn_mfma_f32_16x16x32_bf16(r.Kf[kk], Vf[c2][kk], sacc[c2], 0, 0, 0);
        u32x2 w; w.x = cvt_pk_bf16(sacc[c2][0], sacc[c2][1]); w.y = cvt_pk_bf16(sacc[c2][2], sacc[c2][3]);
        *(u32x2*)(sn + (c2 * 16 + fr) * SP + dt * 16 + fq * 4) = w; }
}
__device__ __forceinline__ void phase4(const Params& p, unsigned char* shm, int vid) {
    const int tid = fresh_tid(), lane = tid & 63, wave = __builtin_amdgcn_readfirstlane(tid >> 6);
    bf16_t* vT = (bf16_t*)shm;
    bf16_t* ST = (bf16_t*)(shm + 2 * 32 * VP * 2);
    bf16_t* Z = (bf16_t*)(p.ws + WS_Z);
    const bf16_t* QD = (const bf16_t*)((unsigned char*)p.out + DO_QD); const bf16_t* KET = (const bf16_t*)((unsigned char*)p.out + DO_KET);
    const bf16_t* PG = (const bf16_t*)(p.ws + WS_PG); const float* DEC = (const float*)(p.ws + WS_DEC);
    bf16_t* O = (bf16_t*)((unsigned char*)p.out + DO_O);
    const int fr = lane & 15, fq = lane >> 4, it = wave >> 1, ct = wave & 1, dt = wave;
    {
        const int b = vid & 7, h = vid >> 6, s = (vid >> 3) & 7, bh = b * 4 + h;
        for (int i = tid; i < 32 * SP; i += 512) ST[i] = 0;
        f32x4 sacc[2]; sacc[0] = (f32x4){0.f, 0.f, 0.f, 0.f}; sacc[1] = sacc[0];
        const int vj = tid >> 3, vc = (tid & 7) * 4;
        const int u0 = bh * 64, r0 = b * SEQ;
        ScanRegs r0s, r1s, r2s, r3s;
#define SCAN_LD(R, N) do { const int n_ = (N) < 64 ? (N) : 63; scan_load(R, PG, QD, KET, DEC, Z, u0 + n_, r0 + n_ * 64, h, s, it, dt, fr, fq, vj, vc); } while (0)
#define SCAN_ST(R, N) scan_step(R, sacc, vT, ST, O, (N) & 1, r0 + (N) * 64, h, s, it, ct, dt, fr, fq, vj, vc)
        SCAN_LD(r0s, 0); SCAN_LD(r1s, 1); SCAN_LD(r2s, 2);
        for (int n = 0; n < 64; n += 4) {
            SCAN_LD(r3s, n + 3); SCAN_ST(r0s, n);
            SCAN_LD(r0s, n + 4); SCAN_ST(r1s, n + 1);
            SCAN_LD(r1s, n + 5); SCAN_ST(r2s, n + 2);
            SCAN_LD(r2s, n + 6); SCAN_ST(r3s, n + 3);
        }
#undef SCAN_LD
#undef SCAN_ST
        __syncthreads();
    }
    {
        const int item = (vid >> 3) * 512 + tid;
        const int cv = item & 127, b = vid & 7, t0 = (item >> 7) * 32, c = cv * 8, w = 2 << (cv >> 5);
        const bf16_t* src = Z + (size_t)b * SEQ * ZLD + ZC_PV + c; bf16_t* dst = Z + (size_t)b * SEQ * ZLD + ZC_POOLED + c;
        f32x4 s0 = (f32x4){0.f, 0.f, 0.f, 0.f}, s1 = s0;
        for (int j = 1; j <= w; ++j) { const int t = t0 - j; if (t >= 0) { f32x4 a0, a1; unpack8(*(const u32x4*)(src + (size_t)t * ZLD), a0, a1); s0 += a0; s1 += a1; } }
        for (int tb = t0; tb < t0 + 32; tb += 8) {
            u32x4 cur[8], old[8];
#pragma unroll
            for (int e = 0; e < 8; ++e) { cur[e] = *(const u32x4*)(src + (size_t)(tb + e) * ZLD);
                const int to = tb + e - w; old[e] = *(const u32x4*)(src + (size_t)(to >= 0 ? to : 0) * ZLD); }
#pragma unroll
            for (int e = 0; e < 8; ++e) { const int t = tb + e;
                f32x4 c0, c1; unpack8(cur[e], c0, c1); s0 += c0; s1 += c1;
                if (t - w >= 0) { f32x4 a0, a1; unpack8(old[e], a0, a1); s0 -= a0; s1 -= a1; }
                const float inv = 1.0f / (float)((t + 1 < w) ? (t + 1) : w);
                *(u32x4*)(dst + (size_t)t * ZLD) = pack8(s0 * inv - c0, s1 * inv - c1); }
        }
    }
}

__device__ __forceinline__ void phase5a(const Params& p, int vid) {
    const int tid = fresh_tid(), lane = tid & 63, wave = __builtin_amdgcn_readfirstlane(tid >> 6);
    bf16_t* Z = (bf16_t*)(p.ws + WS_Z); const bf16_t* O = (const bf16_t*)((unsigned char*)p.out + DO_O);
    for (int kr = 0; kr < 16; ++kr) {
        const int row = (vid & 7) * SEQ + (vid >> 3) * 8 + wave + 256 * kr;
#pragma unroll
        for (int j = 0; j < 2; ++j) { const int c = 8 * lane + 512 * j;
            f32x4 o0, o1; unpack8(*(const u32x4*)(O + (size_t)row * 1024 + c), o0, o1);
            float ss = (o0[0] * o0[0] + o0[1] * o0[1]) + (o0[2] * o0[2] + o0[3] * o0[3]) + (o1[0] * o1[0] + o1[1] * o1[1]) + (o1[2] * o1[2] + o1[3] * o1[3]);
#pragma unroll
            for (int of = 1; of < 32; of <<= 1) ss += __shfl_xor(ss, of);
            const float rstd = 1.0f / sqrtf(ss * (1.f / 256.f) + EPSV);
            const f32x4 g0 = *(const f32x4*)(p.g_gla + (c & 255)), g1 = *(const f32x4*)(p.g_gla + (c & 255) + 4);
            bf16_t* zp = Z + (size_t)row * ZLD + ZC_SGG + c;
            f32x4 s0, s1; unpack8(*(const u32x4*)zp, s0, s1);
            *(u32x4*)zp = pack8(o0 * rstd * g0 * s0, o1 * rstd * g1 * s1); }
    }
}
__device__ __forceinline__ void phase8(const Params& p, int vid) {
    const int tid = fresh_tid(), lane = tid & 63, wave = __builtin_amdgcn_readfirstlane(tid >> 6);
    const bf16_t* Z = (const bf16_t*)(p.ws + WS_Z); const float* gate = (const float*)(p.ws + WS_MOD) + (size_t)(vid & 7) * 3072 + 2048;
    f32x4 gt[4], gf[4];
#pragma unroll
    for (int j = 0; j < 4; ++j) { gt[j] = *(const f32x4*)(gate + 4 * lane + 256 * j); gf[j] = *(const f32x4*)(p.g_final + 4 * lane + 256 * j); }
    for (int kr = 0; kr < 16; kr += 2) {
        const int rowa = (vid & 7) * SEQ + (vid >> 3) * 8 + wave + 256 * kr, rowb = rowa + 256;
        f32x4 xa[4], xb[4]; u32x2 ua[4], ub[4];
#pragma unroll
        for (int j = 0; j < 4; ++j) { xa[j] = *(const f32x4*)(p.x + (size_t)rowa * DM + 4 * lane + 256 * j); xb[j] = *(const f32x4*)(p.x + (size_t)rowb * DM + 4 * lane + 256 * j);
            ua[j] = *(const u32x2*)(Z + (size_t)rowa * ZLD + ZC_T + 4 * lane + 256 * j); ub[j] = *(const u32x2*)(Z + (size_t)rowb * ZLD + ZC_T + 4 * lane + 256 * j); }
        float sa = 0.f, sb = 0.f;
#pragma unroll
        for (int j = 0; j < 4; ++j) {
            xa[j] += gt[j] * (f32x4){bf_lo(ua[j].x), bf_hi(ua[j].x), bf_lo(ua[j].y), bf_hi(ua[j].y)};
            xb[j] += gt[j] * (f32x4){bf_lo(ub[j].x), bf_hi(ub[j].x), bf_lo(ub[j].y), bf_hi(ub[j].y)};
            sa += (xa[j][0] * xa[j][0] + xa[j][1] * xa[j][1]) + (xa[j][2] * xa[j][2] + xa[j][3] * xa[j][3]);
            sb += (xb[j][0] * xb[j][0] + xb[j][1] * xb[j][1]) + (xb[j][2] * xb[j][2] + xb[j][3] * xb[j][3]); }
        const float ra = 1.0f / sqrtf(wave_sum(sa) * (1.f / DM) + EPSV), rb = 1.0f / sqrtf(wave_sum(sb) * (1.f / DM) + EPSV);
#pragma unroll
        for (int j = 0; j < 4; ++j) { *(f32x4*)(p.out + (size_t)rowa * DM + 4 * lane + 256 * j) = xa[j] * ra * gf[j];
                                      *(f32x4*)(p.out + (size_t)rowb * DM + 4 * lane + 256 * j) = xb[j] * rb * gf[j]; }
    }
}

#define GRID_SEAM() do { __builtin_amdgcn_fence(__ATOMIC_RELEASE, "agent"); asm volatile("s_waitcnt vmcnt(0) lgkmcnt(0)" ::: "memory"); __syncthreads(); \
    bar_epoch += 1u; \
    if (threadIdx.x == 0) { __hip_atomic_fetch_add(bar_ctr, 1u, __ATOMIC_RELEASE, __HIP_MEMORY_SCOPE_AGENT); \
        const unsigned target_ = bar_epoch * gridDim.x; \
        while (__hip_atomic_load(bar_ctr, __ATOMIC_RELAXED, __HIP_MEMORY_SCOPE_AGENT) < target_) __builtin_amdgcn_s_sleep(2); \
        __builtin_amdgcn_fence(__ATOMIC_ACQUIRE, "agent"); } \
    __syncthreads(); __builtin_amdgcn_fence(__ATOMIC_ACQUIRE, "agent"); asm volatile("s_waitcnt vmcnt(0)" ::: "memory"); } while (0)
#define XCD_SEAM() do { asm volatile("s_waitcnt vmcnt(0) lgkmcnt(0)" ::: "memory"); __syncthreads(); \
    x_epoch += 1u; \
    if (threadIdx.x == 0) { __hip_atomic_fetch_add(x_ctr, 1u, __ATOMIC_RELAXED, __HIP_MEMORY_SCOPE_AGENT); \
        const unsigned target_ = x_epoch * 32u; \
        while (__hip_atomic_load(x_ctr, __ATOMIC_RELAXED, __HIP_MEMORY_SCOPE_AGENT) < target_) __builtin_amdgcn_s_sleep(1); \
        __builtin_amdgcn_fence(__ATOMIC_ACQUIRE, "agent"); asm volatile("s_waitcnt vmcnt(0)" ::: "memory"); } \
    __syncthreads(); } while (0)
#define SEAM() do { if (affine) XCD_SEAM(); else GRID_SEAM(); } while (0)
__global__ void __launch_bounds__(512, 2) hybrid_fwd(Params p) {
    extern __shared__ __attribute__((aligned(16))) unsigned char shm[];
    cg::grid_group grid = cg::this_grid();
    const int tid0 = threadIdx.x;
    LAS unsigned char* lds = (LAS unsigned char*)shm;
    bf16_t* Z = (bf16_t*)(p.ws + WS_Z);
    const int G = gridDim.x;
    unsigned* bar_ctr = (unsigned*)(p.ws + WS_BAR); unsigned bar_epoch = 0u;
    unsigned* census = bar_ctr + 16;
    if (tid0 == 0) { const unsigned xcc = (unsigned)__builtin_amdgcn_s_getreg((3 << 11) | 20) & 0xFu;
        const unsigned ord = __hip_atomic_fetch_add(census + (xcc & 7u), 1u, __ATOMIC_RELAXED, __HIP_MEMORY_SCOPE_AGENT);
        ((unsigned*)shm)[0] = xcc & 7u; ((unsigned*)shm)[1] = ord; }
    __syncthreads();
    const unsigned my_xcc = (unsigned)__builtin_amdgcn_readfirstlane((int)((unsigned*)shm)[0]), my_ord = (unsigned)__builtin_amdgcn_readfirstlane((int)((unsigned*)shm)[1]);
    __syncthreads();
    grid.sync();

    phase0(p, shm);
    GRID_SEAM();
    bool affine; int vid;
    {
        unsigned cnt[8];
#pragma unroll
        for (int x = 0; x < 8; ++x) cnt[x] = __hip_atomic_load(census + x, __ATOMIC_RELAXED, __HIP_MEMORY_SCOPE_AGENT);
        if (my_ord < 32u) vid = (int)(my_ord * 8u + my_xcc);
        else { unsigned k = my_ord - 32u;
#pragma unroll
            for (int x = 0; x < 8; ++x) if ((unsigned)x < my_xcc && cnt[x] > 32u) k += cnt[x] - 32u;
            vid = -1;
#pragma unroll
            for (int x = 0; x < 8; ++x) { const unsigned holes = cnt[x] < 32u ? 32u - cnt[x] : 0u;
                if (vid < 0) { if (k < holes) vid = (int)((cnt[x] + k) * 8u + (unsigned)x); else k -= holes; } }
            if (vid < 0) vid = (int)blockIdx.x; }
        vid = __builtin_amdgcn_readfirstlane(vid);
        bool a = (G == 256);
#pragma unroll
        for (int x = 0; x < 8; ++x) a = a && (cnt[x] == 32u);
        affine = a;
    }
    unsigned* x_ctr = bar_ctr + 64 * (1 + (vid & 7)); unsigned x_epoch = 0u;
    const int cid = vid;
    phase1(p, shm, vid);
    SEAM();
    {
        pg8::Gemm g{(const bf16_t*)((unsigned char*)p.out + DO_H), (const bf16_t*)(p.ws + WS_WINT), 1024, 1024, 1024, 0};
        pg8::StaticOrder S; S.init(MTOK, ZN, G, cid); EpiZ E{Z};
        pg8::gemm_phase<EpiZ>(lds, g, S, E);
#ifdef DBL_G1
        pg8::gemm_phase<EpiZ>(lds, g, S, E);
#endif
    }
    SEAM();
    phase3(p, shm, vid);
#ifdef DBL_P3
    __syncthreads(); phase3(p, shm, vid);
#endif
    SEAM();
    phase4(p, shm, vid);
#ifdef DBL_P4
    __syncthreads(); phase4(p, shm, vid);
#endif
    SEAM();
    phase5a(p, vid);
    {
        pg8::Gemm g{Z + ZC_POOLED, (const bf16_t*)(p.ws + WS_WPGT), ZLD, 256, 256, 512};
        pg8::StaticOrder S; S.init(MTOK, 1024, G, cid); EpiPool E{Z, p.pool_scale};
        pg8::gemm_phase<EpiPool>(lds, g, S, E);
    }
    SEAM();
    {
        pg8::Gemm g3{Z + ZC_YPOOL, (const bf16_t*)(p.ws + WS_WPOT), ZLD, 1024, 1024, 0};
        pg8::StaticOrder S; S.init(MTOK, 1024, G, cid); EpiT E3{Z};
        pg8::gemm_phase<EpiT>(lds, g3, S, E3);
        pg8::Gemm g4{Z + ZC_YGLA, (const bf16_t*)(p.ws + WS_WGOT), ZLD, 1024, 1024, 0};
        EpiMerge E4{Z};
        pg8::gemm_phase<EpiMerge>(lds, g4, S, E4);
#ifdef DBL_P6
        pg8::gemm_phase<EpiT>(lds, g3, S, E3);
        pg8::gemm_phase<EpiMerge>(lds, g4, S, E4);
#endif
    }
    SEAM();
    {
        pg8::Gemm g{Z + ZC_MERGED, (const bf16_t*)(p.ws + WS_WOT), ZLD, 1024, 1024, 0};
        pg8::StaticOrder S; S.init(MTOK, 1024, G, cid); EpiU E{Z};
        pg8::gemm_phase<EpiU>(lds, g, S, E);
    }
    SEAM();
    phase8(p, vid);
}

extern "C" void kernel_launch(void* const* d_in, const int* in_sizes, int n_in, void* d_out, int out_size, void* d_ws, size_t ws_size, hipStream_t stream) {
    static int grid_blocks = 0;
    if (grid_blocks == 0) {
        if (ws_size < WS_END) { fprintf(stderr, "kernel_launch: workspace too small (%zu < %zu)\n", ws_size, (size_t)WS_END); grid_blocks = -1; return; }
        int dev = 0, cus = 0, per_cu = 0;
        hipGetDevice(&dev);
        hipDeviceGetAttribute(&cus, hipDeviceAttributeMultiprocessorCount, dev);
        if (hipFuncSetAttribute((const void*)hybrid_fwd, hipFuncAttributeMaxDynamicSharedMemorySize, LDS_BYTES) != hipSuccess) { fprintf(stderr, "kernel_launch: hipFuncSetAttribute failed\n"); grid_blocks = -1; return; }
        hipOccupancyMaxActiveBlocksPerMultiprocessor(&per_cu, (const void*)hybrid_fwd, 512, LDS_BYTES);
        if (per_cu < 1) per_cu = 1;
        grid_blocks = cus * per_cu;
        if (grid_blocks != 256) { fprintf(stderr, "kernel_launch: built for a 256-workgroup resident grid, got %d\n", grid_blocks); if (grid_blocks > 256) grid_blocks = 256; }
        (void)hipGetLastError();
    }
    if (grid_blocks < 0) return;
    Params p{};
    p.x = (const float*)d_in[0]; p.c = (const float*)d_in[1]; p.g_norm = (const float*)d_in[2]; p.w_ada = (const float*)d_in[3]; p.b_ada = (const float*)d_in[4];
    p.w_in = (const float*)d_in[5]; p.w_pg = (const float*)d_in[6]; p.pool_scale = (const float*)d_in[7]; p.w_up = (const float*)d_in[8]; p.b_alpha = (const float*)d_in[9];
    p.g_gla = (const float*)d_in[10]; p.w_po = (const float*)d_in[11]; p.w_go = (const float*)d_in[12]; p.w_out = (const float*)d_in[13]; p.g_final = (const float*)d_in[14];
    p.out = (float*)d_out; p.ws = (unsigned char*)d_ws;
    (void)hipMemsetAsync((unsigned char*)d_ws + WS_BAR, 0, 4096, stream);
    void* args[] = {&p};
    hipError_t e = hipLaunchCooperativeKernel((const void*)hybrid_fwd, dim3(grid_blocks), dim3(512), args, LDS_BYTES, stream);
    if (e != hipSuccess) fprintf(stderr, "cooperative launch failed: %s (grid %d)\n", hipGetErrorString(e), grid_blocks);
}
```

```cpp
#include <hip/hip_runtime.h>
#include <hip/hip_cooperative_groups.h>
#include <cstdio>
namespace cg = cooperative_groups;

#define LAS __attribute__((address_space(3)))
typedef unsigned short bf16_t;
typedef short bf16x8 __attribute__((ext_vector_type(8)));
typedef float f32x4 __attribute__((ext_vector_type(4)));
typedef unsigned u32x4 __attribute__((ext_vector_type(4)));
typedef unsigned u32x2 __attribute__((ext_vector_type(2)));

constexpr int DM = 1024, NB = 8, SEQ = 4096, MTOK = NB * SEQ;
constexpr int INW = 7184, ZN = 7168, ZLD = 7168;
constexpr int ZC_PV = 0, ZC_SPG = 1024, ZC_Q = 2048, ZC_K = 2560, ZC_V = 3072, ZC_SGG = 4096, ZC_SMP = 5120, ZC_SMG = 6144;
constexpr int ZC_YPOOL = 0, ZC_MERGED = 1024, ZC_POOLED = 2048, ZC_T = 2048, ZC_YGLA = 4096;
constexpr float EPSV = 1e-6f;
constexpr size_t WS_Z = 0;
constexpr size_t WS_WINT = WS_Z + (size_t)MTOK * ZLD * 2;
constexpr size_t WS_WPGT = WS_WINT + (size_t)ZN * 1024 * 2;
constexpr size_t WS_WPOT = WS_WPGT + (size_t)1024 * 256 * 2;
constexpr size_t WS_WGOT = WS_WPOT + (size_t)1024 * 1024 * 2;
constexpr size_t WS_WOT = WS_WGOT + (size_t)1024 * 1024 * 2;
constexpr size_t WS_MOD = WS_WOT + (size_t)1024 * 1024 * 2;
constexpr size_t WS_ALOW = WS_MOD + (size_t)8 * 3072 * 4;
constexpr size_t WS_PG = WS_ALOW + (size_t)MTOK * 16 * 4;
constexpr size_t WS_DEC = WS_PG + (size_t)2048 * 4096 * 2;
constexpr size_t WS_BAR = WS_DEC + (size_t)2048 * 128 * 4;
constexpr size_t WS_END = WS_BAR + 4096;
constexpr size_t DO_H = 0;
constexpr size_t DO_QD = 0;
constexpr size_t DO_KET = (size_t)MTOK * 512 * 2;
constexpr size_t DO_O = (size_t)MTOK * 1024 * 2;
constexpr int LDS_BYTES = 131072;

struct Params {
    const float *x, *c, *g_norm, *w_ada, *b_ada, *w_in, *w_pg, *pool_scale, *w_up, *b_alpha, *g_gla, *w_po, *w_go, *w_out, *g_final;
    float* out; unsigned char* ws;
};

typedef __bf16 bf16x2_t __attribute__((ext_vector_type(2)));
typedef float f32x2_t __attribute__((ext_vector_type(2)));
__device__ __forceinline__ unsigned cvt_pk_bf16(float lo, float hi) { const f32x2_t f = {lo, hi}; const bf16x2_t b = __builtin_convertvector(f, bf16x2_t); return __builtin_bit_cast(unsigned, b); }
__device__ __forceinline__ float bf_lo(unsigned u) { return __uint_as_float(u << 16); }
__device__ __forceinline__ float bf_hi(unsigned u) { return __uint_as_float(u & 0xffff0000u); }
__device__ __forceinline__ float bf1(bf16_t b) { return __uint_as_float(((unsigned)b) << 16); }
__device__ __forceinline__ float wave_sum(float v) {
#pragma unroll
    for (int o = 1; o < 64; o <<= 1) v += __shfl_xor(v, o);
    return v;
}
__device__ __forceinline__ float sigmoid_f(float x) { return __builtin_amdgcn_rcpf(1.0f + __expf(-x)); }
__device__ __forceinline__ float silu_f(float x) { return x * sigmoid_f(x); }
#define LDS_WAIT() asm volatile("s_waitcnt lgkmcnt(0)" ::: "memory")
__device__ __forceinline__ int fresh_tid() { int t = threadIdx.x; asm volatile("" : "+v"(t)); return t; }

namespace pg8 {
constexpr int BM = 256, BK = 64, HALF = 128, HTB = HALF * BK * 2, STAGE_BYTES = 8 * HTB, NXCD = 8, WGM = 8;
__device__ __forceinline__ int lds_byte(int r, int c) { const int st = (r >> 4) * 2 + (c >> 5), rr = r & 15, cc = c & 31, ob = rr * 64 + cc * 2; return st * 1024 + (ob ^ (((ob >> 9) & 1) << 5)); }
__device__ __forceinline__ void stage_rc(int b, int& R, int& C) { const int st = b / 1024, sb = b % 1024, swz = sb ^ (((sb >> 9) & 1) << 5); R = (st >> 1) * 16 + swz / 64; C = (st & 1) * 32 + (swz % 64) / 2; }
__device__ __forceinline__ int perm32(int rho) { const int n = rho >> 4, i = rho & 15; return 8 * (i >> 2) + 4 * n + (i & 3); }
struct Unit { int pm, pn; };
struct Gemm { const bf16_t* A; const bf16_t* Bt; int lda, ldb, K, a_pn_off; };
struct StaticOrder {
    int nM, nN, nwg, G, c;
    __device__ void init(int M, int N, int G_, int c_) { nM = M / BM; nN = N / BM; nwg = nM * nN; G = G_; c = c_; }
    __device__ bool next(int i, Unit& u) const {
        const long L = (long)i * G + c; if (L >= nwg) return false;
        int wgid = (int)L; { const int q = nwg / NXCD, r = nwg % NXCD, xcd = wgid % NXCD, off = wgid / NXCD; wgid = (xcd < r ? xcd * (q + 1) : r * (q + 1) + (xcd - r) * q) + off; }
        const int nig = WGM * nN, gid = wgid / nig, fm = gid * WGM, gsz = (nM - fm) < WGM ? (nM - fm) : WGM;
        u.pm = fm + ((wgid % nig) % gsz); u.pn = (wgid % nig) / gsz; return true;
    }
};

template <class Epi>
__device__ __forceinline__ void gemm_phase(LAS unsigned char* lds, const Gemm g, const StaticOrder& S, const Epi& E) {
    const int tid = fresh_tid(), wid = __builtin_amdgcn_readfirstlane(tid >> 6), lane = tid & 63, wr = wid >> 2, wc = wid & 3, fr = lane & 15, fq = lane >> 4;
    int nt = g.K / BK; asm volatile("" : "+s"(nt));
    unsigned voffA[2], voffB[2];
#pragma unroll
    for (int i = 0; i < 2; ++i) { int R, C; stage_rc(tid * 16 + i * 8192, R, C); const int Rb = Epi::PERM ? ((R & ~31) + perm32(R & 31)) : R;
        voffA[i] = (unsigned)(R * g.lda + C) * 2u; voffB[i] = (unsigned)(Rb * g.ldb + C) * 2u; }
    const size_t kstep = (size_t)(BK * 2);
    const size_t hA = (size_t)HALF * g.lda * 2, hB = (size_t)HALF * g.ldb * 2;
    const size_t tA = 2 * hA, tB = 2 * hB;
    const unsigned ldsw = (unsigned)wid * 1024u;
    const int aoff = lds_byte(wr * 64 + fr, fq * 8), boff = lds_byte(wc * 32 + fr, fq * 8);
#define PG8_SA(b, h) (((b) * 2 + (h)) * HTB)
#define PG8_SB(b, h) ((4 + (b) * 2 + (h)) * HTB)
#define PG8_STAGE(bufoff, gbase, voff) do { _Pragma("unroll") for (int _i = 0; _i < 2; ++_i) \
        __builtin_amdgcn_global_load_lds((const unsigned*)((const char*)(gbase) + (voff)[_i]), (LAS unsigned*)(lds + (bufoff) + ldsw + _i * 8192), 16, 0, 0); } while (0)
#define PG8_LDA(dst, b, h) do { _Pragma("unroll") for (int m = 0; m < 4; ++m) _Pragma("unroll") for (int k = 0; k < 2; ++k) dst[m][k] = *(const LAS bf16x8*)(lds + PG8_SA(b, h) + aoff + m * 2048 + k * 1024); } while (0)
#define PG8_LDB(dst, b, h) do { _Pragma("unroll") for (int n = 0; n < 2; ++n) _Pragma("unroll") for (int k = 0; k < 2; ++k) dst[n][k] = *(const LAS bf16x8*)(lds + PG8_SB(b, h) + boff + n * 2048 + k * 1024); } while (0)
#define PG8_MMA(ai, bj, At, Bt) do { __builtin_amdgcn_s_setprio(1); _Pragma("unroll") for (int m = 0; m < 4; ++m) _Pragma("unroll") for (int n = 0; n < 2; ++n) _Pragma("unroll") for (int k = 0; k < 2; ++k) \
        acc[ai][bj][m][n] = __builtin_amdgcn_mfma_f32_16x16x32_bf16(Bt[n][k], At[m][k], acc[ai][bj][m][n], 0, 0, 0); __builtin_amdgcn_s_setprio(0); } while (0)
#define PG8_WAIT_V(n) asm volatile("s_waitcnt vmcnt(" #n ")" ::: "memory")
#define PG8_WAIT_L(n) asm volatile("s_waitcnt lgkmcnt(" #n ")" ::: "memory")
#define PG8_BAR __builtin_amdgcn_s_barrier()
#define PG8_SCHED __builtin_amdgcn_sched_barrier(0)
    Unit cur, nxt; int ui = 0;
    if (!S.next(0, cur)) return;
    f32x4 acc[2][2][4][2];
#pragma unroll
    for (int a = 0; a < 2; ++a)
#pragma unroll
        for (int b = 0; b < 2; ++b)
#pragma unroll
            for (int m = 0; m < 4; ++m)
#pragma unroll
                for (int n = 0; n < 2; ++n) acc[a][b][m][n] = (f32x4){0.f, 0.f, 0.f, 0.f};
    bf16x8 At[4][2], B0[2][2], B1[2][2];
    const char* cA = (const char*)g.A + (size_t)cur.pm * tA + (size_t)cur.pn * g.a_pn_off; const char* cB = (const char*)g.Bt + (size_t)cur.pn * tB;
    PG8_STAGE(PG8_SB(0, 0), cB, voffB); PG8_STAGE(PG8_SA(0, 0), cA, voffA); PG8_STAGE(PG8_SB(0, 1), cB + hB, voffB); PG8_STAGE(PG8_SA(0, 1), cA + hA, voffA);
    if (wr == 1) PG8_BAR;
    PG8_WAIT_V(4); PG8_BAR;
    PG8_STAGE(PG8_SB(1, 0), cB + kstep, voffB); PG8_STAGE(PG8_SA(1, 0), cA + kstep, voffA); PG8_STAGE(PG8_SB(1, 1), cB + hB + kstep, voffB);
    PG8_WAIT_V(6); PG8_BAR;
    for (;;) {
        const bool has_next = S.next(ui + 1, nxt);
        const char* nA = has_next ? (const char*)g.A + (size_t)nxt.pm * tA + (size_t)nxt.pn * g.a_pn_off : cA; const char* nB = has_next ? (const char*)g.Bt + (size_t)nxt.pn * tB : cB;
        for (int t = 0; t < nt; t += 2) {
            const bool last = (t == nt - 2);
            const char* a1 = cA + (size_t)(t + 1) * kstep;
            const char* a2 = last ? nA : cA + (size_t)(t + 2) * kstep; const char* b2 = last ? nB : cB + (size_t)(t + 2) * kstep;
            const char* a3 = a2 + kstep; const char* b3 = b2 + kstep;
            PG8_LDB(B0, 0, 0); PG8_SCHED; PG8_LDA(At, 0, 0); PG8_STAGE(PG8_SA(1, 1), a1 + hA, voffA);
            PG8_WAIT_L(8); PG8_BAR; PG8_WAIT_L(0); PG8_MMA(0, 0, At, B0); PG8_BAR; PG8_SCHED;
            PG8_LDB(B1, 0, 1); PG8_STAGE(PG8_SB(0, 0), b2, voffB);
            PG8_BAR; PG8_WAIT_L(0); PG8_MMA(0, 1, At, B1); PG8_BAR;
            PG8_LDA(At, 0, 1); PG8_STAGE(PG8_SA(0, 0), a2, voffA);
            PG8_BAR; PG8_WAIT_L(0); PG8_MMA(1, 0, At, B0); PG8_BAR; PG8_SCHED;
            PG8_STAGE(PG8_SB(0, 1), b2 + hB, voffB);
            PG8_WAIT_V(6); PG8_BAR; PG8_MMA(1, 1, At, B1); PG8_BAR;
            PG8_LDB(B0, 1, 0); PG8_SCHED; PG8_LDA(At, 1, 0); PG8_STAGE(PG8_SA(0, 1), a2 + hA, voffA);
            PG8_WAIT_L(8); PG8_BAR; PG8_WAIT_L(0); PG8_MMA(0, 0, At, B0); PG8_BAR; PG8_SCHED;
            PG8_LDB(B1, 1, 1); PG8_STAGE(PG8_SB(1, 0), b3, voffB);
            PG8_BAR; PG8_WAIT_L(0); PG8_MMA(0, 1, At, B1); PG8_BAR;
            PG8_LDA(At, 1, 1); PG8_STAGE(PG8_SA(1, 0), a3, voffA);
            PG8_BAR; PG8_WAIT_L(0); PG8_MMA(1, 0, At, B0); PG8_BAR; PG8_SCHED;
            PG8_STAGE(PG8_SB(1, 1), b3 + hB, voffB);
            PG8_WAIT_V(6); PG8_BAR; PG8_MMA(1, 1, At, B1); PG8_BAR;
        }
        E(acc, cur, wr, wc, fr, fq);
        if (!has_next) break;
#pragma unroll
        for (int a = 0; a < 2; ++a)
#pragma unroll
            for (int b = 0; b < 2; ++b)
#pragma unroll
                for (int m = 0; m < 4; ++m)
#pragma unroll
                    for (int n = 0; n < 2; ++n) acc[a][b][m][n] = (f32x4){0.f, 0.f, 0.f, 0.f};
        cur = nxt; cA = nA; cB = nB; ++ui;
    }
    PG8_WAIT_V(0);
    if (wr == 0) PG8_BAR;
    PG8_BAR;
#undef PG8_SA
#undef PG8_SB
#undef PG8_STAGE
#undef PG8_LDA
#undef PG8_LDB
#undef PG8_MMA
#undef PG8_WAIT_V
#undef PG8_WAIT_L
#undef PG8_BAR
#undef PG8_SCHED
}
}

typedef f32x4 AccT[2][2][4][2];
__device__ __forceinline__ u32x4 pack8(f32x4 v0, f32x4 v1) { u32x4 w; w.x = cvt_pk_bf16(v0[0], v0[1]); w.y = cvt_pk_bf16(v0[2], v0[3]); w.z = cvt_pk_bf16(v1[0], v1[1]); w.w = cvt_pk_bf16(v1[2], v1[3]); return w; }
__device__ __forceinline__ void unpack8(u32x4 w, f32x4& v0, f32x4& v1) { v0 = (f32x4){bf_lo(w.x), bf_hi(w.x), bf_lo(w.y), bf_hi(w.y)}; v1 = (f32x4){bf_lo(w.z), bf_hi(w.z), bf_lo(w.w), bf_hi(w.w)}; }

struct EpiZ {
    static constexpr bool PERM = true;
    bf16_t* Z;
    template <int ACT> __device__ __forceinline__ void run(const AccT& acc, const pg8::Unit& u, int, int, int, int) const {
        const int t_ = fresh_tid(), l_ = t_ & 63, w_ = __builtin_amdgcn_readfirstlane(t_ >> 6), wr = w_ >> 2, wc = w_ & 3, fr = l_ & 15, fq = l_ >> 4;
        const int row0 = u.pm * 256 + wr * 64 + fr, col0 = u.pn * 256 + wc * 32 + 8 * fq;
#pragma unroll
        for (int ai = 0; ai < 2; ++ai)
#pragma unroll
            for (int m = 0; m < 4; ++m) { bf16_t* rowp = Z + (size_t)(row0 + ai * 128 + m * 16) * ZLD + col0;
#pragma unroll
                for (int bj = 0; bj < 2; ++bj) { f32x4 v0 = acc[ai][bj][m][0], v1 = acc[ai][bj][m][1];
                    if (ACT == 1) {
#pragma unroll
                        for (int j = 0; j < 4; ++j) { v0[j] = silu_f(v0[j]); v1[j] = silu_f(v1[j]); } }
                    if (ACT == 2) {
#pragma unroll
                        for (int j = 0; j < 4; ++j) { v0[j] = sigmoid_f(v0[j]); v1[j] = sigmoid_f(v1[j]); } }
                    *(u32x4*)(rowp + bj * 128) = pack8(v0, v1); } }
    }
    __device__ __forceinline__ void operator()(const AccT& acc, const pg8::Unit& u, int wr, int wc, int fr, int fq) const {
        const int pn = u.pn;
        if ((pn >= 4 && pn < 8) || (pn >= 16 && pn < 20)) run<1>(acc, u, wr, wc, fr, fq);
        else if (pn >= 20) run<2>(acc, u, wr, wc, fr, fq);
        else run<0>(acc, u, wr, wc, fr, fq);
    }
};
struct EpiPool {
    static constexpr bool PERM = true;
    bf16_t* Z; const float* pool_scale;
    __device__ __forceinline__ void operator()(const AccT& acc, const pg8::Unit& u, int, int, int, int) const {
        const int t_ = fresh_tid(), l_ = t_ & 63, w_ = __builtin_amdgcn_readfirstlane(t_ >> 6), wr = w_ >> 2, wc = w_ & 3, fr = l_ & 15, fq = l_ >> 4;
        const int row0 = u.pm * 256 + wr * 64 + fr, col0 = u.pn * 256 + wc * 32 + 8 * fq;
#pragma unroll
        for (int bj = 0; bj < 2; ++bj) { const f32x4 s0 = *(const f32x4*)(pool_scale + col0 + bj * 128), s1 = *(const f32x4*)(pool_scale + col0 + bj * 128 + 4);
#pragma unroll
            for (int ai = 0; ai < 2; ++ai)
#pragma unroll
                for (int m = 0; m < 4; ++m) { bf16_t* rowp = Z + (size_t)(row0 + ai * 128 + m * 16) * ZLD + col0 + bj * 128;
                    f32x4 g0, g1; unpack8(*(const u32x4*)(rowp + ZC_SPG), g0, g1);
                    *(u32x4*)(rowp + ZC_YPOOL) = pack8(acc[ai][bj][m][0] * s0 * g0, acc[ai][bj][m][1] * s1 * g1);
                    if (m & 1) asm volatile("" ::: "memory"); } }
    }
};
struct EpiT {
    static constexpr bool PERM = true;
    bf16_t* Z;
    __device__ __forceinline__ void operator()(const AccT& acc, const pg8::Unit& u, int, int, int, int) const {
        const int t_ = fresh_tid(), l_ = t_ & 63, w_ = __builtin_amdgcn_readfirstlane(t_ >> 6), wr = w_ >> 2, wc = w_ & 3, fr = l_ & 15, fq = l_ >> 4;
        const int row0 = u.pm * 256 + wr * 64 + fr, col0 = u.pn * 256 + wc * 32 + 8 * fq;
#pragma unroll
        for (int ai = 0; ai < 2; ++ai)
#pragma unroll
            for (int m = 0; m < 4; ++m)
#pragma unroll
                for (int bj = 0; bj < 2; ++bj) { bf16_t* rowp = Z + (size_t)(row0 + ai * 128 + m * 16) * ZLD + col0 + bj * 128;
                    f32x4 g0, g1; unpack8(*(const u32x4*)(rowp + ZC_SMP), g0, g1);
                    *(u32x4*)(rowp + ZC_T) = pack8(acc[ai][bj][m][0] * g0, acc[ai][bj][m][1] * g1);
                    if (bj) asm volatile("" ::: "memory"); }
    }
};
struct EpiMerge {
    static constexpr bool PERM = true;
    bf16_t* Z;
    __device__ __forceinline__ void operator()(const AccT& acc, const pg8::Unit& u, int, int, int, int) const {
        const int t_ = fresh_tid(), l_ = t_ & 63, w_ = __builtin_amdgcn_readfirstlane(t_ >> 6), wr = w_ >> 2, wc = w_ & 3, fr = l_ & 15, fq = l_ >> 4;
        const int row0 = u.pm * 256 + wr * 64 + fr, col0 = u.pn * 256 + wc * 32 + 8 * fq;
#pragma unroll
        for (int ai = 0; ai < 2; ++ai)
#pragma unroll
            for (int m = 0; m < 4; ++m)
#pragma unroll
                for (int bj = 0; bj < 2; ++bj) { bf16_t* rowp = Z + (size_t)(row0 + ai * 128 + m * 16) * ZLD + col0 + bj * 128;
                    f32x4 g0, g1, t0, t1; unpack8(*(const u32x4*)(rowp + ZC_SMG), g0, g1); unpack8(*(const u32x4*)(rowp + ZC_T), t0, t1);
                    *(u32x4*)(rowp + ZC_MERGED) = pack8(t0 + acc[ai][bj][m][0] * g0, t1 + acc[ai][bj][m][1] * g1);
                    if (bj) asm volatile("" ::: "memory"); }
    }
};
struct EpiU {
    static constexpr bool PERM = true;
    bf16_t* Z;
    __device__ __forceinline__ void operator()(const AccT& acc, const pg8::Unit& u, int, int, int, int) const {
        const int t_ = fresh_tid(), l_ = t_ & 63, w_ = __builtin_amdgcn_readfirstlane(t_ >> 6), wr = w_ >> 2, wc = w_ & 3, fr = l_ & 15, fq = l_ >> 4;
        const int row0 = u.pm * 256 + wr * 64 + fr, col0 = u.pn * 256 + wc * 32 + 8 * fq;
#pragma unroll
        for (int ai = 0; ai < 2; ++ai)
#pragma unroll
            for (int m = 0; m < 4; ++m)
#pragma unroll
                for (int bj = 0; bj < 2; ++bj)
                    *(u32x4*)(Z + (size_t)(row0 + ai * 128 + m * 16) * ZLD + col0 + bj * 128 + ZC_T) = pack8(acc[ai][bj][m][0], acc[ai][bj][m][1]);
    }
};

__device__ __forceinline__ void tr_item(const float* W, int ldw, int K, bf16_t* WT, int row_off, float* scr, int kb, int nb, int lane) {
    const int k0 = 64 * kb, n0 = 32 * nb;
#pragma unroll 8
    for (int i = 0; i < 32; ++i) { const int kk = 2 * i + (lane >> 5); scr[kk * 33 + (lane & 31)] = W[(size_t)(k0 + kk) * ldw + n0 + (lane & 31)]; }
    LDS_WAIT();
    const int c = lane & 7;
#pragma unroll
    for (int j = 0; j < 4; ++j) { const int n = (lane >> 3) + 8 * j; const float* s = scr + (8 * c) * 33 + n;
        u32x4 o; o.x = cvt_pk_bf16(s[0 * 33], s[1 * 33]); o.y = cvt_pk_bf16(s[2 * 33], s[3 * 33]); o.z = cvt_pk_bf16(s[4 * 33], s[5 * 33]); o.w = cvt_pk_bf16(s[6 * 33], s[7 * 33]);
        *(u32x4*)(WT + (size_t)(row_off + n0 + n) * K + k0 + 8 * c) = o; }
    LDS_WAIT();
}
__device__ __forceinline__ void phase0(const Params& p, unsigned char* shm) {
    const int tid = fresh_tid(), lane = tid & 63, wave = __builtin_amdgcn_readfirstlane(tid >> 6);
    float* mod = (float*)(p.ws + WS_MOD);
    if (blockIdx.x < 192) {
        float* sc = (float*)shm; float* red = (float*)(shm + 32768);
        for (int i = tid; i < 8192; i += 512) sc[i] = silu_f(p.c[i]);
        __syncthreads();
        const int col = tid & 15, ks = tid >> 4, n = blockIdx.x * 16 + col;
        float a[8];
#pragma unroll
        for (int b = 0; b < 8; ++b) a[b] = 0.f;
#pragma unroll 4
        for (int kk = 0; kk < 32; ++kk) { const int k = ks * 32 + kk; const float w = p.w_ada[(size_t)k * 3072 + n];
#pragma unroll
            for (int b = 0; b < 8; ++b) a[b] += sc[b * 1024 + k] * w; }
#pragma unroll
        for (int b = 0; b < 8; ++b) red[(ks * 8 + b) * 16 + col] = a[b];
        __syncthreads();
        if (tid < 128) { const int b = tid >> 4, cc = tid & 15, nn = blockIdx.x * 16 + cc; float s = p.b_ada[nn];
            for (int k2 = 0; k2 < 32; ++k2) s += red[(k2 * 8 + b) * 16 + cc];
            mod[b * 3072 + nn] = s; }
        __syncthreads();
    }
    float* scr = (float*)(shm + wave * 8448);
    const int gw = blockIdx.x * 8 + wave, NGW = gridDim.x * 8;
    bf16_t* WinT = (bf16_t*)(p.ws + WS_WINT); bf16_t* WpgT = (bf16_t*)(p.ws + WS_WPGT);
    bf16_t* WpoT = (bf16_t*)(p.ws + WS_WPOT); bf16_t* WgoT = (bf16_t*)(p.ws + WS_WGOT); bf16_t* WoT = (bf16_t*)(p.ws + WS_WOT);
    constexpr int I1 = 16 * 160, I2 = 16 * 64, I3 = 4 * 4 * 8, I4 = 16 * 32;
    for (int it = gw; it < I1 + I2 + I3 + 3 * I4; it += NGW) {
        int r = it;
        if (r < I1) { tr_item(p.w_in, INW, 1024, WinT, 0, scr, r / 160, r % 160, lane); continue; } r -= I1;
        if (r < I2) { tr_item(p.w_in + 5136, INW, 1024, WinT, 5120, scr, r / 64, r % 64, lane); continue; } r -= I2;
        if (r < I3) { const int g = r >> 5, q = r & 31; tr_item(p.w_pg + (size_t)g * 65536, 256, 256, WpgT, g * 256, scr, q >> 3, q & 7, lane); continue; } r -= I3;
        if (r < I4) { tr_item(p.w_po, 1024, 1024, WpoT, 0, scr, r >> 5, r & 31, lane); continue; } r -= I4;
        if (r < I4) { tr_item(p.w_go, 1024, 1024, WgoT, 0, scr, r >> 5, r & 31, lane); continue; } r -= I4;
        tr_item(p.w_out, 1024, 1024, WoT, 0, scr, r >> 5, r & 31, lane);
    }
}

__device__ __forceinline__ void phase1(const Params& p, unsigned char* shm, int vid) {
    const int tid = fresh_tid(), lane = tid & 63, wave = __builtin_amdgcn_readfirstlane(tid >> 6);
    float* WA = (float*)shm;
    for (int i = tid; i < 16384; i += 512) { const int k = i >> 4, r = i & 15; WA[(((k & 3) << 8) + (k >> 2)) * 16 + r] = p.w_in[(size_t)k * INW + 5120 + r]; }
    __syncthreads();
    const float* mod = (const float*)(p.ws + WS_MOD);
    bf16_t* H = (bf16_t*)((unsigned char*)p.out + DO_H); float* ALOW = (float*)(p.ws + WS_ALOW);
    const int b = vid & 7;
    for (int kr = 0; kr < 16; kr += 2) {
        const int row0 = b * SEQ + (vid >> 3) * 8 + wave + 256 * kr;
        f32x4 v[2][4]; float ssq[2];
#pragma unroll
        for (int q = 0; q < 2; ++q) { const f32x4* xr = (const f32x4*)(p.x + (size_t)(row0 + 256 * q) * DM) + lane;
#pragma unroll
            for (int j = 0; j < 4; ++j) v[q][j] = xr[64 * j]; }
#pragma unroll
        for (int q = 0; q < 2; ++q) { float s_ = 0.f;
#pragma unroll
            for (int j = 0; j < 4; ++j) s_ += (v[q][j][0] * v[q][j][0] + v[q][j][1] * v[q][j][1]) + (v[q][j][2] * v[q][j][2] + v[q][j][3] * v[q][j][3]);
            ssq[q] = s_; }
        ssq[0] = wave_sum(ssq[0]); ssq[1] = wave_sum(ssq[1]);
#pragma unroll
        for (int q = 0; q < 2; ++q) { const int row = row0 + 256 * q;
            const float rstd = 1.0f / sqrtf(ssq[q] * (1.f / DM) + EPSV);
            float acc[16];
#pragma unroll
            for (int r = 0; r < 16; ++r) acc[r] = 0.f;
#pragma unroll
            for (int j = 0; j < 4; ++j) { const int k = 4 * lane + 256 * j;
                const f32x4 g4 = *(const f32x4*)(p.g_norm + k), sh = *(const f32x4*)(mod + b * 3072 + k), sc = *(const f32x4*)(mod + b * 3072 + 1024 + k);
                const f32x4 h = v[q][j] * rstd * g4 * (sc + 1.0f) + sh;
                u32x2 w; w.x = cvt_pk_bf16(h[0], h[1]); w.y = cvt_pk_bf16(h[2], h[3]);
                *(u32x2*)(H + (size_t)row * DM + k) = w;
#pragma unroll
                for (int e = 0; e < 4; ++e) { const f32x4* wp = (const f32x4*)(WA + (e * 256 + lane + 64 * j) * 16);
#pragma unroll
                    for (int q4 = 0; q4 < 4; ++q4) { const f32x4 wv = wp[q4];
                        acc[4 * q4 + 0] += h[e] * wv[0]; acc[4 * q4 + 1] += h[e] * wv[1]; acc[4 * q4 + 2] += h[e] * wv[2]; acc[4 * q4 + 3] += h[e] * wv[3]; }
                    asm volatile("" ::: "memory"); } }
            float a8[8], a4[4], a2[2], a1;
#pragma unroll
            for (int r = 0; r < 8; ++r) { const bool hi = lane & 32; const float snd = hi ? acc[r] : acc[r + 8], kp = hi ? acc[r + 8] : acc[r]; a8[r] = kp + __shfl_xor(snd, 32); }
#pragma unroll
            for (int r = 0; r < 4; ++r) { const bool hi = lane & 16; const float snd = hi ? a8[r] : a8[r + 4], kp = hi ? a8[r + 4] : a8[r]; a4[r] = kp + __shfl_xor(snd, 16); }
#pragma unroll
            for (int r = 0; r < 2; ++r) { const bool hi = lane & 8; const float snd = hi ? a4[r] : a4[r + 2], kp = hi ? a4[r + 2] : a4[r]; a2[r] = kp + __shfl_xor(snd, 8); }
            { const bool hi = lane & 4; const float snd = hi ? a2[0] : a2[1], kp = hi ? a2[1] : a2[0]; a1 = kp + __shfl_xor(snd, 4); }
            a1 += __shfl_xor(a1, 2); a1 += __shfl_xor(a1, 1);
            const int rk = ((lane >> 5) & 1) * 8 + ((lane >> 4) & 1) * 4 + ((lane >> 3) & 1) * 2 + ((lane >> 2) & 1);
            if ((lane & 3) == 0) ALOW[(size_t)row * 16 + rk] = a1; }
    }
}

constexpr int QP = 136;
__device__ __forceinline__ void phase3(const Params& p, unsigned char* shm, int vid) {
    const int tid = fresh_tid(), lane = tid & 63, wave = __builtin_amdgcn_readfirstlane(tid >> 6);
    bf16_t* qd_s = (bf16_t*)shm; bf16_t* ki_s = (bf16_t*)(shm + 64 * QP * 2);
    float* al_s = (float*)(shm + 2 * 64 * QP * 2); float* gsum = al_s + 1024;
    const bf16_t* Z = (const bf16_t*)(p.ws + WS_Z); const float* ALOW = (const float*)(p.ws + WS_ALOW);
    bf16_t* QD = (bf16_t*)((unsigned char*)p.out + DO_QD); bf16_t* KET = (bf16_t*)((unsigned char*)p.out + DO_KET);
    bf16_t* PG = (bf16_t*)(p.ws + WS_PG); float* DEC = (float*)(p.ws + WS_DEC);
    const int d = tid & 127, tg = tid >> 7;
    for (int ku = 0; ku < 8; ++ku) {
        const int u = (vid & 7) * 256 + (vid >> 3) + 32 * ku;
        const int bh = u >> 6, n = u & 63, b = bh >> 2, h = bh & 3; const int row0 = b * SEQ + n * 64;
        if (tid < 256) *(f32x4*)(al_s + tid * 4) = *(const f32x4*)(ALOW + (size_t)row0 * 16 + tid * 4);
        float wup[16];
#pragma unroll
        for (int r = 0; r < 16; ++r) wup[r] = p.w_up[r * 512 + h * 128 + d];
        const float ba = p.b_alpha[h * 128 + d];
        __syncthreads();
        float bl[16]; float run = 0.f;
#pragma unroll
        for (int i = 0; i < 16; ++i) { const float* al = al_s + (tg * 16 + i) * 16; float xg = ba;
#pragma unroll
            for (int r = 0; r < 16; ++r) xg += al[r] * wup[r];
            const float ls = fminf(xg, 0.f) - __logf(1.0f + __expf(-fabsf(xg)));
            run += ls * 0.0625f; bl[i] = run; }
        gsum[tg * 128 + d] = run;
        __syncthreads();
        float prefix = 0.f, total = 0.f;
#pragma unroll
        for (int g2 = 0; g2 < 4; ++g2) { const float gs = gsum[g2 * 128 + d]; total += gs; if (g2 < tg) prefix += gs; }
        float kev[16];
#pragma unroll
        for (int i = 0; i < 16; ++i) { const int t = tg * 16 + i; const float bb = bl[i] + prefix;
            const float q = bf1(Z[(size_t)(row0 + t) * ZLD + ZC_Q + h * 128 + d]), k = bf1(Z[(size_t)(row0 + t) * ZLD + ZC_K + h * 128 + d]);
            const float qdv = q * 0.08838834764831845f * __expf(bb), kiv = k * __expf(-bb); kev[i] = k * __expf(total - bb);
            const unsigned pk = cvt_pk_bf16(qdv, kiv);
            qd_s[t * QP + d] = (bf16_t)(pk & 0xffffu); ki_s[t * QP + d] = (bf16_t)(pk >> 16); }
        { u32x4 w0, w1;
          w0.x = cvt_pk_bf16(kev[0], kev[1]); w0.y = cvt_pk_bf16(kev[2], kev[3]); w0.z = cvt_pk_bf16(kev[4], kev[5]); w0.w = cvt_pk_bf16(kev[6], kev[7]);
          w1.x = cvt_pk_bf16(kev[8], kev[9]); w1.y = cvt_pk_bf16(kev[10], kev[11]); w1.z = cvt_pk_bf16(kev[12], kev[13]); w1.w = cvt_pk_bf16(kev[14], kev[15]);
          bf16_t* kp = KET + ((((size_t)u * 8 + (d >> 4)) * 2 + (tg >> 1)) * 64 + (tg & 1) * 32 + (d & 15)) * 8; *(u32x4*)kp = w0; *(u32x4*)(kp + 128) = w1; }
        if (tg == 0) DEC[u * 128 + d] = __expf(total);
        __syncthreads();
        const int it = wave >> 1, fr = lane & 15, fq = lane >> 4;
        bf16x8 aq[4];
#pragma unroll
        for (int kk = 0; kk < 4; ++kk) aq[kk] = *(const bf16x8*)(qd_s + (it * 16 + fr) * QP + kk * 32 + fq * 8);
        if ((wave & 1) == 0) {
#pragma unroll
            for (int kk = 0; kk < 4; ++kk) *(bf16x8*)(QD + ((((size_t)u * 4 + it) * 4 + kk) * 64 + lane) * 8) = aq[kk]; }
#pragma unroll
        for (int j2 = 0; j2 < 2; ++j2) { const int jt = (wave & 1) * 2 + j2; f32x4 acc = (f32x4){0.f, 0.f, 0.f, 0.f};
            if (jt <= it) {
#pragma unroll
                for (int kk = 0; kk < 4; ++kk) { const bf16x8 bk = *(const bf16x8*)(ki_s + (jt * 16 + fr) * QP + kk * 32 + fq * 8);
                    acc = __builtin_amdgcn_mfma_f32_16x16x32_bf16(bk, aq[kk], acc, 0, 0, 0); } }
            const int i = it * 16 + fr, j0 = jt * 16 + fq * 4;
#pragma unroll
            for (int e = 0; e < 4; ++e) if (j0 + e > i) acc[e] = 0.f;
            u32x2 w; w.x = cvt_pk_bf16(acc[0], acc[1]); w.y = cvt_pk_bf16(acc[2], acc[3]);
            *(u32x2*)(PG + ((((size_t)u * 4 + it) * 2 + (jt >> 1)) * 64 + ((jt & 1) * 2 + (fq >> 1)) * 16 + fr) * 8 + (fq & 1) * 4) = w; }
        __syncthreads();
    }
}

constexpr int VP = 72, SP = 136;
struct ScanRegs { bf16x8 Pf[2], Qf[4], Kf[2]; f32x4 decv; u32x2 vv; };
__device__ __forceinline__ void scan_load(ScanRegs& r, const bf16_t* PG, const bf16_t* QD, const bf16_t* KET, const float* DEC, const bf16_t* Z,
                                          int u, int row0, int h, int s, int it, int dt, int fr, int fq, int vj, int vc) {
#pragma unroll
    for (int kk = 0; kk < 2; ++kk) r.Pf[kk] = *(const bf16x8*)(PG + ((((size_t)u * 4 + it) * 2 + kk) * 64 + fq * 16 + fr) * 8);
#pragma unroll
    for (int kk = 0; kk < 4; ++kk) r.Qf[kk] = *(const bf16x8*)(QD + ((((size_t)u * 4 + it) * 4 + kk) * 64 + fq * 16 + fr) * 8);
#pragma unroll
    for (int kk = 0; kk < 2; ++kk) r.Kf[kk] = *(const bf16x8*)(KET + ((((size_t)u * 8 + dt) * 2 + kk) * 64 + fq * 16 + fr) * 8);
    r.decv = *(const f32x4*)(DEC + u * 128 + dt * 16 + fq * 4);
    r.vv = *(const u32x2*)(Z + (size_t)(row0 + vj) * ZLD + ZC_V + h * 256 + s * 32 + vc);
}
__device__ __forceinline__ void scan_step(const ScanRegs& r, f32x4 (&sacc)[2], bf16_t* vT, bf16_t* ST, bf16_t* O, int buf, int row0, int h, int s,
                                          int it, int ct, int dt, int fr, int fq, int vj, int vc) {
    bf16_t* vb = vT + buf * 32 * VP;
    vb[(vc + 0) * VP + vj] = (bf16_t)(r.vv.x & 0xffffu); vb[(vc + 1) * VP + vj] = (bf16_t)(r.vv.x >> 16);
    vb[(vc + 2) * VP + vj] = (bf16_t)(r.vv.y & 0xffffu); vb[(vc + 3) * VP + vj] = (bf16_t)(r.vv.y >> 16);
    __syncthreads();
    bf16x8 Vf[2][2], Vo[2], Sf[4];
#pragma unroll
    for (int c2 = 0; c2 < 2; ++c2)
#pragma unroll
        for (int kk = 0; kk < 2; ++kk) Vf[c2][kk] = *(const bf16x8*)(vb + (c2 * 16 + fr) * VP + kk * 32 + fq * 8);
#pragma unroll
    for (int kk = 0; kk < 2; ++kk) Vo[kk] = *(const bf16x8*)(vb + (ct * 16 + fr) * VP + kk * 32 + fq * 8);
    const bf16_t* sb = ST + buf * 32 * SP;
#pragma unroll
    for (int kk = 0; kk < 4; ++kk) Sf[kk] = *(const bf16x8*)(sb + (ct * 16 + fr) * SP + kk * 32 + fq * 8);
    f32x4 oacc = (f32x4){0.f, 0.f, 0.f, 0.f};
#pragma unroll
    for (int kk = 0; kk < 2; ++kk) oacc = __builtin_amdgcn_mfma_f32_16x16x32_bf16(Vo[kk], r.Pf[kk], oacc, 0, 0, 0);
#pragma unroll
    for (int kk = 0; kk < 4; ++kk) oacc = __builtin_amdgcn_mfma_f32_16x16x32_bf16(Sf[kk], r.Qf[kk], oacc, 0, 0, 0);
    { u32x2 w; w.x = cvt_pk_bf16(oacc[0], oacc[1]); w.y = cvt_pk_bf16(oacc[2], oacc[3]);
      *(u32x2*)(O + (size_t)(row0 + it * 16 + fr) * 1024 + h * 256 + s * 32 + ct * 16 + fq * 4) = w; }
    bf16_t* sn = ST + (buf ^ 1) * 32 * SP;
#pragma unroll
    for (int c2 = 0; c2 < 2; ++c2) { sacc[c2] = sacc[c2] * r.decv;
#pragma unroll
        for (int kk = 0; kk < 2; ++kk) sacc[c2] = __builtin_amdgcn_mfma_f32_16x16x32_bf16(r.Kf[kk], Vf[c2][kk], sacc[c2], 0, 0, 0);
        u32x2 w; w.x = cvt_pk_bf16(sacc[c2][0], sacc[c2][1]); w.y = cvt_pk_bf16(sacc[c2][2], sacc[c2][3]);
        *(u32x2*)(sn + (c2 * 16 + fr) * SP + dt * 16 + fq * 4) = w; }
}
__device__ __forceinline__ void phase4(const Params& p, unsigned char* shm, int vid) {
    const int tid = fresh_tid(), lane = tid & 63, wave = __builtin_amdgcn_readfirstlane(tid >> 6);
    bf16_t* vT = (bf16_t*)shm;
    bf16_t* ST = (bf16_t*)(shm + 2 * 32 * VP * 2);
    bf16_t* Z = (bf16_t*)(p.ws + WS_Z);
    const bf16_t* QD = (const bf16_t*)((unsigned char*)p.out + DO_QD); const bf16_t* KET = (const bf16_t*)((unsigned char*)p.out + DO_KET);
    const bf16_t* PG = (const bf16_t*)(p.ws + WS_PG); const float* DEC = (const float*)(p.ws + WS_DEC);
    bf16_t* O = (bf16_t*)((unsigned char*)p.out + DO_O);
    const int fr = lane & 15, fq = lane >> 4, it = wave >> 1, ct = wave & 1, dt = wave;
    {
        const int b = vid & 7, h = vid >> 6, s = (vid >> 3) & 7, bh = b * 4 + h;
        for (int i = tid; i < 32 * SP; i += 512) ST[i] = 0;
        f32x4 sacc[2]; sacc[0] = (f32x4){0.f, 0.f, 0.f, 0.f}; sacc[1] = sacc[0];
        const int vj = tid >> 3, vc = (tid & 7) * 4;
        const int u0 = bh * 64, r0 = b * SEQ;
        ScanRegs r0s, r1s, r2s, r3s;
#define SCAN_LD(R, N) do { const int n_ = (N) < 64 ? (N) : 63; scan_load(R, PG, QD, KET, DEC, Z, u0 + n_, r0 + n_ * 64, h, s, it, dt, fr, fq, vj, vc); } while (0)
#define SCAN_ST(R, N) scan_step(R, sacc, vT, ST, O, (N) & 1, r0 + (N) * 64, h, s, it, ct, dt, fr, fq, vj, vc)
        SCAN_LD(r0s, 0); SCAN_LD(r1s, 1); SCAN_LD(r2s, 2);
        for (int n = 0; n < 64; n += 4) {
            SCAN_LD(r3s, n + 3); SCAN_ST(r0s, n);
            SCAN_LD(r0s, n + 4); SCAN_ST(r1s, n + 1);
            SCAN_LD(r1s, n + 5); SCAN_ST(r2s, n + 2);
            SCAN_LD(r2s, n + 6); SCAN_ST(r3s, n + 3);
        }
#undef SCAN_LD
#undef SCAN_ST
        __syncthreads();
    }
    {
        const int item = (vid >> 3) * 512 + tid;
        const int cv = item & 127, b = vid & 7, t0 = (item >> 7) * 32, c = cv * 8, w = 2 << (cv >> 5);
        const bf16_t* src = Z + (size_t)b * SEQ * ZLD + ZC_PV + c; bf16_t* dst = Z + (size_t)b * SEQ * ZLD + ZC_POOLED + c;
        f32x4 s0 = (f32x4){0.f, 0.f, 0.f, 0.f}, s1 = s0;
        for (int j = 1; j <= w; ++j) { const int t = t0 - j; if (t >= 0) { f32x4 a0, a1; unpack8(*(const u32x4*)(src + (size_t)t * ZLD), a0, a1); s0 += a0; s1 += a1; } }
        for (int tb = t0; tb < t0 + 32; tb += 8) {
            u32x4 cur[8], old[8];
#pragma unroll
            for (int e = 0; e < 8; ++e) { cur[e] = *(const u32x4*)(src + (size_t)(tb + e) * ZLD);
                const int to = tb + e - w; old[e] = *(const u32x4*)(src + (size_t)(to >= 0 ? to : 0) * ZLD); }
#pragma unroll
            for (int e = 0; e < 8; ++e) { const int t = tb + e;
                f32x4 c0, c1; unpack8(cur[e], c0, c1); s0 += c0; s1 += c1;
                if (t - w >= 0) { f32x4 a0, a1; unpack8(old[e], a0, a1); s0 -= a0; s1 -= a1; }
                const float inv = 1.0f / (float)((t + 1 < w) ? (t + 1) : w);
                *(u32x4*)(dst + (size_t)t * ZLD) = pack8(s0 * inv - c0, s1 * inv - c1); }
        }
    }
}

__device__ __forceinline__ void phase5a(const Params& p, int vid) {
    const int tid = fresh_tid(), lane = tid & 63, wave = __builtin_amdgcn_readfirstlane(tid >> 6);
    bf16_t* Z = (bf16_t*)(p.ws + WS_Z); const bf16_t* O = (const bf16_t*)((unsigned char*)p.out + DO_O);
    const f32x4 g0 = *(const f32x4*)(p.g_gla + ((8 * lane) & 255)), g1 = *(const f32x4*)(p.g_gla + ((8 * lane) & 255) + 4);
    for (int kr = 0; kr < 16; kr += 2) {
        u32x4 ov[4], sv[4];
#pragma unroll
        for (int q = 0; q < 4; ++q) { const int row = (vid & 7) * SEQ + (vid >> 3) * 8 + wave + 256 * (kr + (q >> 1)), c = 8 * lane + 512 * (q & 1);
            ov[q] = *(const u32x4*)(O + (size_t)row * 1024 + c); sv[q] = *(const u32x4*)(Z + (size_t)row * ZLD + ZC_SGG + c); }
#pragma unroll
        for (int q = 0; q < 4; ++q) { const int row = (vid & 7) * SEQ + (vid >> 3) * 8 + wave + 256 * (kr + (q >> 1)), c = 8 * lane + 512 * (q & 1);
            f32x4 o0, o1, s0, s1; unpack8(ov[q], o0, o1); unpack8(sv[q], s0, s1);
            float ss = (o0[0] * o0[0] + o0[1] * o0[1]) + (o0[2] * o0[2] + o0[3] * o0[3]) + (o1[0] * o1[0] + o1[1] * o1[1]) + (o1[2] * o1[2] + o1[3] * o1[3]);
#pragma unroll
            for (int of = 1; of < 32; of <<= 1) ss += __shfl_xor(ss, of);
            const float rstd = 1.0f / sqrtf(ss * (1.f / 256.f) + EPSV);
            *(u32x4*)(Z + (size_t)row * ZLD + ZC_SGG + c) = pack8(o0 * rstd * g0 * s0, o1 * rstd * g1 * s1); }
    }
}
__device__ __forceinline__ void phase8(const Params& p, int vid) {
    const int tid = fresh_tid(), lane = tid & 63, wave = __builtin_amdgcn_readfirstlane(tid >> 6);
    const bf16_t* Z = (const bf16_t*)(p.ws + WS_Z); const float* gate = (const float*)(p.ws + WS_MOD) + (size_t)(vid & 7) * 3072 + 2048;
    f32x4 gt[4], gf[4];
#pragma unroll
    for (int j = 0; j < 4; ++j) { gt[j] = *(const f32x4*)(gate + 4 * lane + 256 * j); gf[j] = *(const f32x4*)(p.g_final + 4 * lane + 256 * j); }
    for (int kr = 0; kr < 16; kr += 2) {
        const int rowa = (vid & 7) * SEQ + (vid >> 3) * 8 + wave + 256 * kr, rowb = rowa + 256;
        f32x4 xa[4], xb[4]; u32x2 ua[4], ub[4];
#pragma unroll
        for (int j = 0; j < 4; ++j) { xa[j] = *(const f32x4*)(p.x + (size_t)rowa * DM + 4 * lane + 256 * j); xb[j] = *(const f32x4*)(p.x + (size_t)rowb * DM + 4 * lane + 256 * j);
            ua[j] = *(const u32x2*)(Z + (size_t)rowa * ZLD + ZC_T + 4 * lane + 256 * j); ub[j] = *(const u32x2*)(Z + (size_t)rowb * ZLD + ZC_T + 4 * lane + 256 * j); }
        float sa = 0.f, sb = 0.f;
#pragma unroll
        for (int j = 0; j < 4; ++j) {
            xa[j] += gt[j] * (f32x4){bf_lo(ua[j].x), bf_hi(ua[j].x), bf_lo(ua[j].y), bf_hi(ua[j].y)};
            xb[j] += gt[j] * (f32x4){bf_lo(ub[j].x), bf_hi(ub[j].x), bf_lo(ub[j].y), bf_hi(ub[j].y)};
            sa += (xa[j][0] * xa[j][0] + xa[j][1] * xa[j][1]) + (xa[j][2] * xa[j][2] + xa[j][3] * xa[j][3]);
            sb += (xb[j][0] * xb[j][0] + xb[j][1] * xb[j][1]) + (xb[j][2] * xb[j][2] + xb[j][3] * xb[j][3]); }
        const float ra = 1.0f / sqrtf(wave_sum(sa) * (1.f / DM) + EPSV), rb = 1.0f / sqrtf(wave_sum(sb) * (1.f / DM) + EPSV);
#pragma unroll
        for (int j = 0; j < 4; ++j) { *(f32x4*)(p.out + (size_t)rowa * DM + 4 * lane + 256 * j) = xa[j] * ra * gf[j];
                                      *(f32x4*)(p.out + (size_t)rowb * DM + 4 * lane + 256 * j) = xb[j] * rb * gf[j]; }
    }
}

#define GRID_SEAM() do { __builtin_amdgcn_fence(__ATOMIC_RELEASE, "agent"); asm volatile("s_waitcnt vmcnt(0) lgkmcnt(0)" ::: "memory"); __syncthreads(); \
    bar_epoch += 1u; \
    if (threadIdx.x == 0) { __hip_atomic_fetch_add(bar_ctr, 1u, __ATOMIC_RELEASE, __HIP_MEMORY_SCOPE_AGENT); \
        const unsigned target_ = bar_epoch * gridDim.x; \
        while (__hip_atomic_load(bar_ctr, __ATOMIC_RELAXED, __HIP_MEMORY_SCOPE_AGENT) < target_) __builtin_amdgcn_s_sleep(2); \
        __builtin_amdgcn_fence(__ATOMIC_ACQUIRE, "agent"); } \
    __syncthreads(); __builtin_amdgcn_fence(__ATOMIC_ACQUIRE, "agent"); asm volatile("s_waitcnt vmcnt(0)" ::: "memory"); } while (0)
#define XCD_SEAM() do { asm volatile("s_waitcnt vmcnt(0) lgkmcnt(0)" ::: "memory"); __syncthreads(); \
    x_epoch += 1u; \
    if (threadIdx.x == 0) { __hip_atomic_fetch_add(x_ctr, 1u, __ATOMIC_RELAXED, __HIP_MEMORY_SCOPE_AGENT); \
        const unsigned target_ = x_epoch * 32u; \
        while (__hip_atomic_load(x_ctr, __ATOMIC_RELAXED, __HIP_MEMORY_SCOPE_AGENT) < target_) __builtin_amdgcn_s_sleep(1); \
        __builtin_amdgcn_fence(__ATOMIC_ACQUIRE, "agent"); asm volatile("s_waitcnt vmcnt(0)" ::: "memory"); } \
    __syncthreads(); } while (0)
#define SEAM() do { if (affine) XCD_SEAM(); else GRID_SEAM(); } while (0)
__global__ void __launch_bounds__(512, 2) hybrid_fwd(Params p) {
    extern __shared__ __attribute__((aligned(16))) unsigned char shm[];
    cg::grid_group grid = cg::this_grid();
    const int tid0 = threadIdx.x;
    LAS unsigned char* lds = (LAS unsigned char*)shm;
    bf16_t* Z = (bf16_t*)(p.ws + WS_Z);
    const int G = gridDim.x;
    unsigned* bar_ctr = (unsigned*)(p.ws + WS_BAR); unsigned bar_epoch = 0u;
    unsigned* census = bar_ctr + 16;
    if (tid0 == 0) { const unsigned xcc = (unsigned)__builtin_amdgcn_s_getreg((3 << 11) | 20) & 0xFu;
        const unsigned ord = __hip_atomic_fetch_add(census + (xcc & 7u), 1u, __ATOMIC_RELAXED, __HIP_MEMORY_SCOPE_AGENT);
        ((unsigned*)shm)[0] = xcc & 7u; ((unsigned*)shm)[1] = ord; }
    __syncthreads();
    const unsigned my_xcc = (unsigned)__builtin_amdgcn_readfirstlane((int)((unsigned*)shm)[0]), my_ord = (unsigned)__builtin_amdgcn_readfirstlane((int)((unsigned*)shm)[1]);
    __syncthreads();

    phase0(p, shm);
    asm volatile("s_waitcnt vmcnt(0) lgkmcnt(0)" ::: "memory");
    grid.sync();
    bool affine; int vid;
    {
        unsigned cnt[8];
#pragma unroll
        for (int x = 0; x < 8; ++x) cnt[x] = __hip_atomic_load(census + x, __ATOMIC_RELAXED, __HIP_MEMORY_SCOPE_AGENT);
        if (my_ord < 32u) vid = (int)(my_ord * 8u + my_xcc);
        else { unsigned k = my_ord - 32u;
#pragma unroll
            for (int x = 0; x < 8; ++x) if ((unsigned)x < my_xcc && cnt[x] > 32u) k += cnt[x] - 32u;
            vid = -1;
#pragma unroll
            for (int x = 0; x < 8; ++x) { const unsigned holes = cnt[x] < 32u ? 32u - cnt[x] : 0u;
                if (vid < 0) { if (k < holes) vid = (int)((cnt[x] + k) * 8u + (unsigned)x); else k -= holes; } }
            if (vid < 0) vid = (int)blockIdx.x; }
        vid = __builtin_amdgcn_readfirstlane(vid);
        bool a = (G == 256);
#pragma unroll
        for (int x = 0; x < 8; ++x) a = a && (cnt[x] == 32u);
        affine = a;
    }
    unsigned* x_ctr = bar_ctr + 64 * (1 + (vid & 7)); unsigned x_epoch = 0u;
    const int cid = vid;
    phase1(p, shm, vid);
    SEAM();
    {
        pg8::Gemm g{(const bf16_t*)((unsigned char*)p.out + DO_H), (const bf16_t*)(p.ws + WS_WINT), 1024, 1024, 1024, 0};
        pg8::StaticOrder S; S.init(MTOK, ZN, G, cid); EpiZ E{Z};
        pg8::gemm_phase<EpiZ>(lds, g, S, E);
#ifdef DBL_G1
        pg8::gemm_phase<EpiZ>(lds, g, S, E);
#endif
    }
    SEAM();
    phase3(p, shm, vid);
#ifdef DBL_P3
    __syncthreads(); phase3(p, shm, vid);
#endif
    SEAM();
    phase4(p, shm, vid);
#ifdef DBL_P4
    __syncthreads(); phase4(p, shm, vid);
#endif
    SEAM();
    phase5a(p, vid);
    {
        pg8::Gemm g{Z + ZC_POOLED, (const bf16_t*)(p.ws + WS_WPGT), ZLD, 256, 256, 512};
        pg8::StaticOrder S; S.init(MTOK, 1024, G, cid); EpiPool E{Z, p.pool_scale};
        pg8::gemm_phase<EpiPool>(lds, g, S, E);
    }
    SEAM();
    {
        pg8::Gemm g3{Z + ZC_YPOOL, (const bf16_t*)(p.ws + WS_WPOT), ZLD, 1024, 1024, 0};
        pg8::StaticOrder S; S.init(MTOK, 1024, G, cid); EpiT E3{Z};
        pg8::gemm_phase<EpiT>(lds, g3, S, E3);
        pg8::Gemm g4{Z + ZC_YGLA, (const bf16_t*)(p.ws + WS_WGOT), ZLD, 1024, 1024, 0};
        EpiMerge E4{Z};
        pg8::gemm_phase<EpiMerge>(lds, g4, S, E4);
#ifdef DBL_P6
        pg8::gemm_phase<EpiT>(lds, g3, S, E3);
        pg8::gemm_phase<EpiMerge>(lds, g4, S, E4);
#endif
    }
    SEAM();
    {
        pg8::Gemm g{Z + ZC_MERGED, (const bf16_t*)(p.ws + WS_WOT), ZLD, 1024, 1024, 0};
        pg8::StaticOrder S; S.init(MTOK, 1024, G, cid); EpiU E{Z};
        pg8::gemm_phase<EpiU>(lds, g, S, E);
    }
    SEAM();
    phase8(p, vid);
}

extern "C" void kernel_launch(void* const* d_in, const int* in_sizes, int n_in, void* d_out, int out_size, void* d_ws, size_t ws_size, hipStream_t stream) {
    static int grid_blocks = 0;
    if (grid_blocks == 0) {
        if (ws_size < WS_END) { fprintf(stderr, "kernel_launch: workspace too small (%zu < %zu)\n", ws_size, (size_t)WS_END); grid_blocks = -1; return; }
        int dev = 0, cus = 0, per_cu = 0;
        hipGetDevice(&dev);
        hipDeviceGetAttribute(&cus, hipDeviceAttributeMultiprocessorCount, dev);
        if (hipFuncSetAttribute((const void*)hybrid_fwd, hipFuncAttributeMaxDynamicSharedMemorySize, LDS_BYTES) != hipSuccess) { fprintf(stderr, "kernel_launch: hipFuncSetAttribute failed\n"); grid_blocks = -1; return; }
        hipOccupancyMaxActiveBlocksPerMultiprocessor(&per_cu, (const void*)hybrid_fwd, 512, LDS_BYTES);
        if (per_cu < 1) per_cu = 1;
        grid_blocks = cus * per_cu;
        if (grid_blocks != 256) { fprintf(stderr, "kernel_launch: built for a 256-workgroup resident grid, got %d\n", grid_blocks); if (grid_blocks > 256) grid_blocks = 256; }
        (void)hipGetLastError();
    }
    if (grid_blocks < 0) return;
    Params p{};
    p.x = (const float*)d_in[0]; p.c = (const float*)d_in[1]; p.g_norm = (const float*)d_in[2]; p.w_ada = (const float*)d_in[3]; p.b_ada = (const float*)d_in[4];
    p.w_in = (const float*)d_in[5]; p.w_pg = (const float*)d_in[6]; p.pool_scale = (const float*)d_in[7]; p.w_up = (const float*)d_in[8]; p.b_alpha = (const float*)d_in[9];
    p.g_gla = (const float*)d_in[10]; p.w_po = (const float*)d_in[11]; p.w_go = (const float*)d_in[12]; p.w_out = (const float*)d_in[13]; p.g_final = (const float*)d_in[14];
    p.out = (float*)d_out; p.ws = (unsigned char*)d_ws;
    (void)hipMemsetAsync((unsigned char*)d_ws + WS_BAR, 0, 4096, stream);
    void* args[] = {&p};
    hipError_t e = hipLaunchCooperativeKernel((const void*)hybrid_fwd, dim3(grid_blocks), dim3(512), args, LDS_BYTES, stream);
    if (e != hipSuccess) fprintf(stderr, "cooperative launch failed: %s (grid %d)\n", hipGetErrorString(e), grid_blocks);
}
```
